# Optimizing an MI355X kernel written in HIP

```python
import math
import jax, jax.numpy as jnp
from jax import lax
import numpy as np

D_MODEL = 2048
BATCH = 4
SEQ = 4096
DEPTH = 2

N_MIXERS = 2
N_HEADS = 8
HEAD_DIM_QK = 128
HEAD_DIM_V = 256
Q_BLOCK = 128
D_RNN = D_MODEL
N_RNN_BLOCKS = 8
RNN_BLOCK = D_RNN // N_RNN_BLOCKS
CONV_WIDTH = 4
RG_C = 8.0
D_FF = 4 * D_MODEL
D_PLE = 256
N_ATTN = (DEPTH + 1) // 2
N_REC = DEPTH // 2
EPS = 1e-6

kernel_name = 'hybrid_diffattn_rglru_sqrelu_ple'


def rmsnorm(x, g):
    xf = x.astype(jnp.float32)
    y = xf * lax.rsqrt(jnp.mean(xf * xf, axis=-1, keepdims=True) + EPS)
    return (y * g.astype(jnp.float32)).astype(x.dtype)


def lambda_init(layer_idx):
    return 0.8 - 0.6 * math.exp(-0.3 * layer_idx)


def diff_attention(xn, w_qkv, g_q, g_k, lam_q1, lam_k1, lam_q2, lam_k2, g_sub, w_o, lam0):
    B, S, _ = xn.shape
    nq = N_HEADS * 2 * HEAD_DIM_QK
    qkv = xn @ w_qkv
    q, k, v = jnp.split(qkv, [nq, 2 * nq], axis=-1)
    q = rmsnorm(q.reshape(B, S, N_HEADS, 2, HEAD_DIM_QK), g_q)
    k = rmsnorm(k.reshape(B, S, N_HEADS, 2, HEAD_DIM_QK), g_k)
    v = v.reshape(B, S, N_HEADS, HEAD_DIM_V)
    lam = (jnp.exp(jnp.sum(lam_q1.astype(jnp.float32) * lam_k1.astype(jnp.float32)))
           - jnp.exp(jnp.sum(lam_q2.astype(jnp.float32) * lam_k2.astype(jnp.float32)))
           + lam0)
    slopes = jnp.exp2(-8.0 * jnp.arange(1, N_HEADS + 1, dtype=jnp.float32) / N_HEADS)
    scale = HEAD_DIM_QK ** -0.5
    n_blk = S // Q_BLOCK
    qb = q.reshape(B, n_blk, Q_BLOCK, N_HEADS, 2, HEAD_DIM_QK).transpose(1, 0, 2, 3, 4, 5)
    k_pos = jnp.arange(S)

    def block(args):
        q_blk, start = args
        s = jnp.einsum('bqhcd,bkhcd->bhcqk', q_blk, k,
                       preferred_element_type=jnp.float32) * scale
        q_pos = start + jnp.arange(Q_BLOCK)
        dist = (q_pos[:, None] - k_pos[None, :]).astype(jnp.float32)
        s = s - slopes[None, :, None, None, None] * dist
        s = jnp.where(dist >= 0, s, -jnp.inf)
        pr = jax.nn.softmax(s, axis=-1)
        attn = pr[:, :, 0] - lam * pr[:, :, 1]
        return jnp.einsum('bhqk,bkhd->bqhd', attn, v,
                          preferred_element_type=jnp.float32)

    o = lax.map(block, (qb, jnp.arange(n_blk) * Q_BLOCK))
    o = o.transpose(1, 0, 2, 3, 4).reshape(B, S, N_HEADS, HEAD_DIM_V)
    o = rmsnorm(o, g_sub) * (1.0 - lam0)
    return o.reshape(B, S, N_HEADS * HEAD_DIM_V).astype(xn.dtype) @ w_o


def rglru_block(xn, w_in, conv_w, conv_b, w_ga, b_ga, w_gx, b_gx, lam, w_o):
    B, S, _ = xn.shape
    u = xn @ w_in
    gate, xr = jnp.split(u, 2, axis=-1)
    y = jax.nn.gelu(gate, approximate=True)
    xc = lax.conv_general_dilated(
        xr, conv_w[:, None, :].astype(xr.dtype), window_strides=(1,),
        padding=[(CONV_WIDTH - 1, 0)], dimension_numbers=('NWC', 'WIO', 'NWC'),
        feature_group_count=D_RNN) + conv_b
    xb = xc.reshape(B, S, N_RNN_BLOCKS, RNN_BLOCK)
    r = jax.nn.sigmoid((jnp.einsum('bsni,nij->bsnj', xb, w_ga).reshape(B, S, D_RNN)
                        + b_ga).astype(jnp.float32))
    ig = jax.nn.sigmoid((jnp.einsum('bsni,nij->bsnj', xb, w_gx).reshape(B, S, D_RNN)
                         + b_gx).astype(jnp.float32))
    log_a = -RG_C * r * jax.nn.softplus(-lam.astype(jnp.float32))
    a = jnp.exp(log_a)
    b = jnp.sqrt(-jnp.expm1(2.0 * log_a)) * (ig * xc.astype(jnp.float32))

    def combine(left, right):
        a1, b1 = left
        a2, b2 = right
        return a1 * a2, a2 * b1 + b2

    _, h = lax.associative_scan(combine, (a, b), axis=1)
    return (h.astype(xn.dtype) * y) @ w_o


def sqrelu_mlp(xn, w_up, w_down):
    return jnp.square(jax.nn.relu(xn @ w_up)) @ w_down


def setup_inputs(seed: int = 0) -> dict:
    key = jax.random.key(seed)
    ks = jax.random.split(key, 32)
    f32 = jnp.float32
    D, H, DK, DV = D_MODEL, N_HEADS, HEAD_DIM_QK, HEAD_DIM_V

    def nrm(k, shape, scale):
        return jax.random.normal(k, shape, f32) * scale

    def gain(k, shape):
        return 1.0 + 0.05 * jax.random.normal(k, shape, f32)

    a_c = jax.random.uniform(ks[20], (N_REC, D_RNN), f32, 0.9, 0.999)
    s = a_c ** (1.0 / RG_C)
    lam_rec = jnp.log(s) - jnp.log1p(-s)
    return {
        'x': jax.random.normal(ks[0], (BATCH, SEQ, D), f32),
        'p': jax.random.normal(ks[1], (DEPTH, BATCH, SEQ, D_PLE), f32),
        'g_mix': gain(ks[2], (DEPTH, D)),
        'g_mlp': gain(ks[3], (DEPTH, D)),
        'g_ple': gain(ks[4], (DEPTH, D)),
        'w_qkv': nrm(ks[5], (N_ATTN, D, 4 * H * DK + H * DV), D ** -0.5),
        'g_q': gain(ks[6], (N_ATTN, DK)),
        'g_k': gain(ks[7], (N_ATTN, DK)),
        'lam_q1': nrm(ks[8], (N_ATTN, DK), 0.1),
        'lam_k1': nrm(ks[9], (N_ATTN, DK), 0.1),
        'lam_q2': nrm(ks[10], (N_ATTN, DK), 0.1),
        'lam_k2': nrm(ks[11], (N_ATTN, DK), 0.1),
        'g_sub': gain(ks[12], (N_ATTN, DV)),
        'w_o_attn': nrm(ks[13], (N_ATTN, H * DV, D), (H * DV) ** -0.5),
        'w_in_rec': nrm(ks[14], (N_REC, D, 2 * D_RNN), D ** -0.5),
        'conv_w': nrm(ks[15], (N_REC, CONV_WIDTH, D_RNN), CONV_WIDTH ** -0.5),
        'conv_b': nrm(ks[16], (N_REC, D_RNN), 0.01),
        'w_gate_a': nrm(ks[17], (N_REC, N_RNN_BLOCKS, RNN_BLOCK, RNN_BLOCK), RNN_BLOCK ** -0.5),
        'b_gate_a': nrm(ks[18], (N_REC, D_RNN), 0.01),
        'w_gate_x': nrm(ks[19], (N_REC, N_RNN_BLOCKS, RNN_BLOCK, RNN_BLOCK), RNN_BLOCK ** -0.5),
        'b_gate_x': nrm(ks[21], (N_REC, D_RNN), 0.01),
        'lam_rec': lam_rec,
        'w_o_rec': nrm(ks[22], (N_REC, D_RNN, D), D_RNN ** -0.5),
        'w_up': nrm(ks[23], (DEPTH, D, D_FF), D ** -0.5),
        'w_down': nrm(ks[24], (DEPTH, D_FF, D), D_FF ** -0.5),
        'w_ple_proj': nrm(ks[25], (DEPTH, D_PLE, D), D_PLE ** -0.5),
        'w_ple_gate': nrm(ks[26], (DEPTH, D, D), D ** -0.5),
    }


def reference(x, p, g_mix, g_mlp, g_ple, w_qkv, g_q, g_k, lam_q1, lam_k1, lam_q2,
              lam_k2, g_sub, w_o_attn, w_in_rec, conv_w, conv_b, w_gate_a, b_gate_a,
              w_gate_x, b_gate_x, lam_rec, w_o_rec, w_up, w_down, w_ple_proj,
              w_ple_gate):
    h = x
    for i in range(DEPTH):
        xn = rmsnorm(h, g_mix[i])
        j = i // N_MIXERS
        if i % N_MIXERS == 0:
            mix = diff_attention(xn, w_qkv[j], g_q[j], g_k[j], lam_q1[j], lam_k1[j],
                                 lam_q2[j], lam_k2[j], g_sub[j], w_o_attn[j],
                                 lambda_init(i))
        else:
            mix = rglru_block(xn, w_in_rec[j], conv_w[j], conv_b[j], w_gate_a[j],
                              b_gate_a[j], w_gate_x[j], b_gate_x[j], lam_rec[j],
                              w_o_rec[j])
        h = h + mix
        h = h + sqrelu_mlp(rmsnorm(h, g_mlp[i]), w_up[i], w_down[i])
        ple_gate = jax.nn.sigmoid(rmsnorm(h, g_ple[i]) @ w_ple_gate[i])
        h = h + ple_gate * (p[i] @ w_ple_proj[i])
    return h
```

```cpp
#include <hip/hip_runtime.h>
#include <hip/hip_cooperative_groups.h>
#include <cstdio>
namespace cg = cooperative_groups;

#define LAS __attribute__((address_space(3)))
typedef unsigned short bf16_t;
typedef short bf16x8 __attribute__((ext_vector_type(8)));
typedef float f32x4 __attribute__((ext_vector_type(4)));
typedef float f32x2 __attribute__((ext_vector_type(2)));
typedef float f32x16 __attribute__((ext_vector_type(16)));
typedef unsigned u32x4 __attribute__((ext_vector_type(4)));
typedef unsigned u32x2 __attribute__((ext_vector_type(2)));
typedef __bf16 bf2_t __attribute__((ext_vector_type(2)));

constexpr int MTOK = 16384, DM = 2048, SEQ = 4096, DFF = 8192, DPLE = 256;
constexpr float EPS = 1e-6f;
constexpr float LOG2E = 1.4426950408889634f;
#ifndef RESID_BF16
#define RESID_BF16 1
#endif
constexpr int NT = 512;
constexpr int LDS_BYTES = 131072 + 1024 + 8192;

constexpr size_t MiB = 1024 * 1024;
constexpr size_t WS_SS = 0;
constexpr size_t WS_SP = 512 * 1024;
constexpr size_t WS_BAR = 768 * 1024;
constexpr size_t WS_QCTR = WS_BAR + 16 * 1024;
constexpr size_t WS_PB = 1 * MiB;
constexpr size_t WS_W = 9 * MiB;
constexpr size_t WS_HBA = 115 * MiB;
constexpr size_t WS_HBB = 179 * MiB;
constexpr size_t WS_T = 243 * MiB;
constexpr size_t WS_END = 563 * MiB;
constexpr size_t W_A = 0;
constexpr size_t W_B = 16 * MiB;
constexpr size_t W_O = 24 * MiB;
constexpr size_t W_UP = 32 * MiB;
constexpr size_t W_DN = 64 * MiB;
constexpr size_t W_PG = 96 * MiB;
constexpr size_t W_PP = 104 * MiB;
constexpr size_t T_QK = 0;
constexpr size_t T_VT = 128 * MiB;
constexpr size_t T_O = 192 * MiB;
constexpr size_t T_U = 0;
constexpr size_t T_PP = 256 * MiB;
constexpr size_t T_Y = 0;
constexpr size_t T_XR = 64 * MiB;
constexpr size_t T_A = 128 * MiB;
constexpr size_t T_BQ = 256 * MiB;
constexpr size_t T_PS = 192 * MiB;

__device__ __forceinline__ unsigned pk_bf16(float lo, float hi) {
    f32x2 v = {lo, hi};
    bf2_t r = __builtin_convertvector(v, bf2_t);
    return __builtin_bit_cast(unsigned, r);
}
__device__ __forceinline__ int opaque_tid(int wv) { int l; asm volatile("v_mbcnt_lo_u32_b32 %0, -1, 0\n\tv_mbcnt_hi_u32_b32 %0, -1, %0" : "=v"(l)); return wv * 64 + l; }
__device__ __forceinline__ float bf_lo(unsigned w) { return __uint_as_float(w << 16); }
__device__ __forceinline__ float bf_hi(unsigned w) { return __uint_as_float(w & 0xffff0000u); }
__device__ __forceinline__ float fast_sigmoid(float x) { return __builtin_amdgcn_rcpf(1.0f + __builtin_amdgcn_exp2f(-x * LOG2E)); }
__device__ __forceinline__ float ss_fix(float raw) { return (float)__float_as_uint(raw) * (1.0f / 256.0f); }
__device__ __forceinline__ unsigned ss_enc(float sq) { return (unsigned)(sq * 256.0f + 0.5f); }
__device__ __forceinline__ float row_rs(const float* ss, int row) { return __builtin_amdgcn_rsqf(ss_fix(ss[row]) * (1.0f / DM) + EPS); }

namespace pg8 {
constexpr int BM = 256, BK = 64, HALF = 128, HTB = HALF * BK * 2, STAGE_BYTES = 8 * HTB, NXCD = 8, WGM = 8;
__device__ __forceinline__ int lds_byte(int r, int c) { const int st = (r >> 4) * 2 + (c >> 5), rr = r & 15, cc = c & 31, ob = rr * 64 + cc * 2; return st * 1024 + (ob ^ (((ob >> 9) & 1) << 5)); }
__device__ __forceinline__ void stage_rc(int b, int& R, int& C) { const int st = b / 1024, sb = b % 1024, swz = sb ^ (((sb >> 9) & 1) << 5); R = (st >> 1) * 16 + swz / 64; C = (st & 1) * 32 + (swz % 64) / 2; }
__device__ __forceinline__ int perm32(int rho) { const int n = rho >> 4, i = rho & 15; return 8 * (i >> 2) + 4 * n + (i & 3); }

struct Unit { int pm, pn; };
struct Gemm { const bf16_t* A; const bf16_t* Bt; int lda, ldb, K, adiag; };

struct StaticOrder {
    int nM, nN, nwg, G, c, wgm;
    __device__ void init(int M, int N, int G_, int c_, int) { nM = M / BM; nN = N / BM; nwg = nM * nN; G = G_; c = c_; wgm = (nN == 8) ? 4 : WGM; }
    __device__ bool next(int i, Unit& u) const {
        const long L = (long)i * G + c; if (L >= nwg) return false;
        int wgid = (int)L; { const int q = nwg / NXCD, r = nwg % NXCD, xcd = wgid % NXCD, off = wgid / NXCD; wgid = (xcd < r ? xcd * (q + 1) : r * (q + 1) + (xcd - r) * q) + off; }
        const int nig = wgm * nN, gid = wgid / nig, fm = gid * wgm, gsz = (nM - fm) < wgm ? (nM - fm) : wgm;
        u.pm = fm + ((wgid % nig) % gsz); u.pn = (wgid % nig) / gsz; return true;
    }
};

template <class Epi>
__device__ __forceinline__ void gemm_phase(LAS unsigned char* lds, const Gemm g, const StaticOrder& S, const Epi& E, int wv) {
    const int tid = opaque_tid(wv), wid = __builtin_amdgcn_readfirstlane(tid >> 6), lane = tid & 63, wr = wid >> 2, wc = wid & 3, fr = lane & 15, fq = lane >> 4;
    const int K = g.K, nt = K / BK;
    unsigned voffA[2], voffB[2];
#pragma unroll
    for (int i = 0; i < 2; ++i) { int R, C; stage_rc(tid * 16 + i * 8192, R, C); const int Rb = Epi::PERM ? ((R & ~31) + perm32(R & 31)) : R;
        voffA[i] = (unsigned)(R * g.lda + C) * 2u; voffB[i] = (unsigned)(Rb * g.ldb + C) * 2u; }
    const bool krev = (g.adiag & 2) != 0;
    const ptrdiff_t kstep = krev ? -(ptrdiff_t)(BK * 2) : (ptrdiff_t)(BK * 2);
    const size_t kbeg = krev ? (size_t)(nt - 1) * (BK * 2) : 0;
    const size_t hstepA = (size_t)HALF * g.lda * 2, hstepB = (size_t)HALF * g.ldb * 2;
    const size_t tstepA = 2 * hstepA, tstepB = 2 * hstepB;
    const unsigned ldsw = (unsigned)wid * 1024u;
    const int aoff = lds_byte(wr * 64 + fr, fq * 8), boff = lds_byte(wc * 32 + fr, fq * 8);
#define PG8_SA(b, h) (((b) * 2 + (h)) * HTB)
#define PG8_SB(b, h) ((4 + (b) * 2 + (h)) * HTB)
#define PG8_STAGE(bufoff, gbase, voff) do { _Pragma("unroll") for (int _i = 0; _i < 2; ++_i) \
        __builtin_amdgcn_global_load_lds((const unsigned*)((const char*)(gbase) + (voff)[_i]), (LAS unsigned*)(lds + (bufoff) + ldsw + _i * 8192), 16, 0, 0); } while (0)
#define PG8_LDA(dst, b, h) do { _Pragma("unroll") for (int m = 0; m < 4; ++m) _Pragma("unroll") for (int k = 0; k < 2; ++k) dst[m][k] = *(const LAS bf16x8*)(lds + PG8_SA(b, h) + aoff + m * 2048 + k * 1024); } while (0)
#define PG8_LDB(dst, b, h) do { _Pragma("unroll") for (int n = 0; n < 2; ++n) _Pragma("unroll") for (int k = 0; k < 2; ++k) dst[n][k] = *(const LAS bf16x8*)(lds + PG8_SB(b, h) + boff + n * 2048 + k * 1024); } while (0)
#define PG8_MMA(ai, bj, At, Bt) do { __builtin_amdgcn_s_setprio(1); _Pragma("unroll") for (int m = 0; m < 4; ++m) _Pragma("unroll") for (int n = 0; n < 2; ++n) _Pragma("unroll") for (int k = 0; k < 2; ++k) \
        acc[ai][bj][m][n] = __builtin_amdgcn_mfma_f32_16x16x32_bf16(Bt[n][k], At[m][k], acc[ai][bj][m][n], 0, 0, 0); __builtin_amdgcn_s_setprio(0); } while (0)
#define PG8_WAIT_V(n) asm volatile("s_waitcnt vmcnt(" #n ")" ::: "memory")
#define PG8_WAIT_L(n) asm volatile("s_waitcnt lgkmcnt(" #n ")" ::: "memory")
#define PG8_BAR __builtin_amdgcn_s_barrier()
#define PG8_SCHED __builtin_amdgcn_sched_barrier(0)
    Unit cur, nxt; int ui = 0;
    if (!S.next(0, cur)) return;
    f32x4 acc[2][2][4][2];
#pragma unroll
    for (int a = 0; a < 2; ++a)
#pragma unroll
        for (int b = 0; b < 2; ++b)
#pragma unroll
            for (int m = 0; m < 4; ++m)
#pragma unroll
                for (int n = 0; n < 2; ++n) acc[a][b][m][n] = (f32x4){0.f, 0.f, 0.f, 0.f};
    bf16x8 At[4][2], B0[2][2], B1[2][2];
    const char* cA = (const char*)g.A + (size_t)cur.pm * tstepA + ((g.adiag & 1) ? (size_t)(cur.pn >> 1) * K * 2 : 0) + kbeg;
    const char* cB = (const char*)g.Bt + (size_t)cur.pn * tstepB + kbeg;
    PG8_STAGE(PG8_SB(0, 0), cB, voffB); PG8_STAGE(PG8_SA(0, 0), cA, voffA); PG8_STAGE(PG8_SB(0, 1), cB + hstepB, voffB); PG8_STAGE(PG8_SA(0, 1), cA + hstepA, voffA);
    if (wr == 1) PG8_BAR;
    PG8_WAIT_V(4); PG8_BAR;
    PG8_STAGE(PG8_SB(1, 0), cB + kstep, voffB); PG8_STAGE(PG8_SA(1, 0), cA + kstep, voffA); PG8_STAGE(PG8_SB(1, 1), cB + hstepB + kstep, voffB);
    PG8_WAIT_V(6); PG8_BAR;
    for (;;) {
        const bool has_next = S.next(ui + 1, nxt);
        const char* nA = has_next ? (const char*)g.A + (size_t)nxt.pm * tstepA + ((g.adiag & 1) ? (size_t)(nxt.pn >> 1) * K * 2 : 0) + kbeg : cA;
        const char* nB = has_next ? (const char*)g.Bt + (size_t)nxt.pn * tstepB + kbeg : cB;
        for (int t = 0; t < nt; t += 2) {
            const bool last = (t == nt - 2);
            const char* a1 = cA + (ptrdiff_t)(t + 1) * kstep;
            const char* a2 = last ? nA : cA + (ptrdiff_t)(t + 2) * kstep; const char* b2 = last ? nB : cB + (ptrdiff_t)(t + 2) * kstep;
            const char* a3 = a2 + kstep; const char* b3 = b2 + kstep;
            PG8_LDB(B0, 0, 0); PG8_SCHED; PG8_LDA(At, 0, 0); PG8_STAGE(PG8_SA(1, 1), a1 + hstepA, voffA);
            PG8_WAIT_L(8); PG8_BAR; PG8_WAIT_L(0); PG8_MMA(0, 0, At, B0); PG8_BAR; PG8_SCHED;
            PG8_LDB(B1, 0, 1); PG8_STAGE(PG8_SB(0, 0), b2, voffB);
            PG8_BAR; PG8_WAIT_L(0); PG8_MMA(0, 1, At, B1); PG8_BAR;
            PG8_LDA(At, 0, 1); PG8_STAGE(PG8_SA(0, 0), a2, voffA);
            PG8_BAR; PG8_WAIT_L(0); PG8_MMA(1, 0, At, B0); PG8_BAR; PG8_SCHED;
            PG8_STAGE(PG8_SB(0, 1), b2 + hstepB, voffB);
            PG8_WAIT_V(6); PG8_BAR; PG8_MMA(1, 1, At, B1); PG8_BAR;
            PG8_LDB(B0, 1, 0); PG8_SCHED; PG8_LDA(At, 1, 0); PG8_STAGE(PG8_SA(0, 1), a2 + hstepA, voffA);
            PG8_WAIT_L(8); PG8_BAR; PG8_WAIT_L(0); PG8_MMA(0, 0, At, B0); PG8_BAR; PG8_SCHED;
            PG8_LDB(B1, 1, 1); PG8_STAGE(PG8_SB(1, 0), b3, voffB);
            PG8_BAR; PG8_WAIT_L(0); PG8_MMA(0, 1, At, B1); PG8_BAR;
            PG8_LDA(At, 1, 1); PG8_STAGE(PG8_SA(1, 0), a3, voffA);
            PG8_BAR; PG8_WAIT_L(0); PG8_MMA(1, 0, At, B0); PG8_BAR; PG8_SCHED;
            PG8_STAGE(PG8_SB(1, 1), b3 + hstepB, voffB);
            PG8_WAIT_V(6); PG8_BAR; PG8_MMA(1, 1, At, B1); PG8_BAR;
        }
        E(acc, cur, wr, wc, fr, fq);
        if (!has_next) break;
#pragma unroll
        for (int a = 0; a < 2; ++a)
#pragma unroll
            for (int b = 0; b < 2; ++b)
#pragma unroll
                for (int m = 0; m < 4; ++m)
#pragma unroll
                    for (int n = 0; n < 2; ++n) acc[a][b][m][n] = (f32x4){0.f, 0.f, 0.f, 0.f};
        cur = nxt; cA = nA; cB = nB; ++ui;
    }
    PG8_WAIT_V(0);
    if (wr == 0) PG8_BAR;
    PG8_BAR;
#undef PG8_SA
#undef PG8_SB
#undef PG8_STAGE
#undef PG8_LDA
#undef PG8_LDB
#undef PG8_MMA
#undef PG8_WAIT_V
#undef PG8_WAIT_L
#undef PG8_BAR
#undef PG8_SCHED
}

template <int ACT, int SM> struct EpiBf16 {
    static constexpr bool PERM = true;
    bf16_t* O; int ldc; const float* ss; int split_cols; size_t split_stride;
    __device__ __forceinline__ void operator()(const f32x4 (&acc)[2][2][4][2], const Unit& u, int wr, int wc, int fr, int fq) const {
        const int row0 = u.pm * BM + wr * 64 + fr; int colt = u.pn * BM; bf16_t* base = O; int tsel = 0;
        if (split_cols) { tsel = colt / split_cols; base += (size_t)tsel * split_stride; colt -= tsel * split_cols; }
        const int col0 = colt + wc * 32 + 8 * fq;
        f32x4 cs[2][2];
        if (SM == 2) {
#pragma unroll
            for (int bj = 0; bj < 2; ++bj)
#pragma unroll
                for (int n = 0; n < 2; ++n) { const f32x4 s = *(const f32x4*)(ss + u.pn * BM + wc * 32 + 8 * fq + bj * HALF + 4 * n);
#pragma unroll
                    for (int j = 0; j < 4; ++j) cs[bj][n][j] = __builtin_amdgcn_rsqf(ss_fix(s[j]) * (1.0f / DM) + EPS); }
        }
        float rsv[8];
#pragma unroll
        for (int it = 0; it < 8; ++it) rsv[it] = (SM == 1) ? ss[row0 + (it >> 2) * HALF + (it & 3) * 16] : 1.0f;
#pragma unroll
        for (int ai = 0; ai < 2; ++ai)
#pragma unroll
            for (int m = 0; m < 4; ++m) { const int row = row0 + ai * HALF + m * 16; float rs = 1.0f; if (SM == 1) rs = __builtin_amdgcn_rsqf(ss_fix(rsv[ai * 4 + m]) * (1.0f / DM) + EPS);
                bf16_t* rowp = base + (size_t)row * ldc + col0;
#pragma unroll
                for (int bj = 0; bj < 2; ++bj) { f32x4 v0 = acc[ai][bj][m][0], v1 = acc[ai][bj][m][1];
                    if (SM == 1) { v0 *= rs; v1 *= rs; }
                    if (SM == 2) { v0 *= cs[bj][0]; v1 *= cs[bj][1]; }
                    if (ACT == 1) {
#pragma unroll
                        for (int j = 0; j < 4; ++j) { const float a = fmaxf(v0[j], 0.f), b = fmaxf(v1[j], 0.f); v0[j] = a * a; v1[j] = b * b; } }
                    if (ACT == 2) { if (tsel == 0) {
#pragma unroll
                        for (int j = 0; j < 4; ++j) { const float a = v0[j], b = v1[j];
                            v0[j] = a * fast_sigmoid(1.5957691216057308f * (a + 0.044715f * a * a * a)); v1[j] = b * fast_sigmoid(1.5957691216057308f * (b + 0.044715f * b * b * b)); } } }
                    u32x4 w; w.x = pk_bf16(v0[0], v0[1]); w.y = pk_bf16(v0[2], v0[3]); w.z = pk_bf16(v1[0], v1[1]); w.w = pk_bf16(v1[2], v1[3]);
                    *(u32x4*)(rowp + bj * HALF) = w; } }
    }
};
struct EpiQK {
    static constexpr bool PERM = true;
    bf16_t* O; const float* ss; const float* gq; const float* gk; LAS float* P;
    __device__ __forceinline__ void operator()(const f32x4 (&acc)[2][2][4][2], const Unit& u, int wr, int wc, int fr, int fq) const {
        const int row0 = u.pm * BM + wr * 64 + fr, col0 = u.pn * BM + wc * 32 + 8 * fq;
        const bool isq = u.pn < 8;
        const float* gp = (isq ? gq : gk) + wc * 32 + 8 * fq;
        const float qs = isq ? 0.08838834764831845f * LOG2E : 1.0f;
        const f32x4 g0 = *(const f32x4*)gp * qs, g1 = *(const f32x4*)(gp + 4) * qs;
        float rsv[8];
#pragma unroll
        for (int it = 0; it < 8; ++it) rsv[it] = __builtin_amdgcn_rsqf(ss_fix(ss[row0 + (it >> 2) * HALF + (it & 3) * 16]) * (1.0f / DM) + EPS);
#pragma unroll
        for (int it = 0; it < 8; ++it) { const int ai = it >> 2, m = it & 3; const float rs = rsv[it];
#pragma unroll
            for (int bj = 0; bj < 2; ++bj) { const f32x4 v0 = acc[ai][bj][m][0] * rs, v1 = acc[ai][bj][m][1] * rs;
                float sq = (v0[0] * v0[0] + v0[1] * v0[1]) + (v0[2] * v0[2] + v0[3] * v0[3]) + (v1[0] * v1[0] + v1[1] * v1[1]) + (v1[2] * v1[2] + v1[3] * v1[3]);
                sq += __shfl_xor(sq, 16); sq += __shfl_xor(sq, 32);
                if (fq == 0) P[((ai * HALF + wr * 64 + m * 16 + fr) * 2 + bj) * 4 + wc] = sq; } }
        asm volatile("s_waitcnt lgkmcnt(0)" ::: "memory"); __builtin_amdgcn_s_barrier(); asm volatile("" ::: "memory");
#pragma unroll
        for (int it = 0; it < 8; ++it) { const int ai = it >> 2, m = it & 3; const float rs = rsv[it]; const int rl = ai * HALF + wr * 64 + m * 16 + fr;
            bf16_t* rowp = O + (size_t)(row0 + ai * HALF + m * 16) * 4096 + col0;
#pragma unroll
            for (int bj = 0; bj < 2; ++bj) { const f32x4 p4 = *(const LAS f32x4*)(P + (rl * 2 + bj) * 4);
                const float rn = __builtin_amdgcn_rsqf(((p4[0] + p4[1]) + (p4[2] + p4[3])) * (1.0f / 128.0f) + EPS) * rs;
                const f32x4 v0 = acc[ai][bj][m][0] * rn * g0, v1 = acc[ai][bj][m][1] * rn * g1;
                u32x4 w; w.x = pk_bf16(v0[0], v0[1]); w.y = pk_bf16(v0[2], v0[3]); w.z = pk_bf16(v1[0], v1[1]); w.w = pk_bf16(v1[2], v1[3]);
                *(u32x4*)(rowp + bj * HALF) = w; } }
    }
};
template <int MODE> struct EpiResid {
    static constexpr bool PERM = false;
    const float* hin; float* hout; bf16_t* hb; float* ss_out; const float* ss_in; const bf16_t* pp;
    __device__ __forceinline__ void operator()(const f32x4 (&acc)[2][2][4][2], const Unit& u, int wr, int wc, int fr, int fq) const {
        const int row0 = u.pm * BM + wr * 64 + fr, col0 = u.pn * BM + wc * 32 + 4 * fq;
        constexpr int RD = (MODE == 0) ? 3 : 2;
        f32x4 hbuf[RD][4]; u32x2 pbuf[RD][4]; float rsb[RD];
#define RES_LOAD(S, it) do { const size_t ro_ = (size_t)(row0 + ((it) >> 2) * HALF + ((it) & 3) * 16) * DM + col0; \
        _Pragma("unroll") for (int q_ = 0; q_ < 4; ++q_) { const size_t off_ = ro_ + (q_ >> 1) * HALF + (q_ & 1) * 16; hbuf[S][q_] = *(const f32x4*)(hin + off_); if (MODE == 1) pbuf[S][q_] = *(const u32x2*)(pp + off_); } \
        if (MODE == 1) rsb[S] = ss_in[row0 + ((it) >> 2) * HALF + ((it) & 3) * 16]; } while (0)
        RES_LOAD(0, 0); if (RD == 3) RES_LOAD(1 % RD, 1);
#pragma unroll
        for (int it = 0; it < 8; ++it) { const int ai = it >> 2, m = it & 3, sc = it % RD;
            if (it + RD - 1 < 8) RES_LOAD((it + RD - 1) % RD, it + RD - 1);
            asm volatile("" ::: "memory");
            const int row = row0 + ai * HALF + m * 16; const size_t ro = (size_t)row * DM + col0;
            float rs = 1.0f; if (MODE == 1) rs = __builtin_amdgcn_rsqf(ss_fix(rsb[sc]) * (1.0f / DM) + EPS);
            float sq = 0.f;
#pragma unroll
            for (int q = 0; q < 4; ++q) { const int bj = q >> 1, n = q & 1; const size_t off = ro + bj * HALF + n * 16;
                f32x4 v = acc[ai][bj][m][n];
                if (MODE == 1) { const u32x2 pw = pbuf[sc][q];
                    v[0] = fast_sigmoid(rs * v[0]) * bf_lo(pw.x); v[1] = fast_sigmoid(rs * v[1]) * bf_hi(pw.x); v[2] = fast_sigmoid(rs * v[2]) * bf_lo(pw.y); v[3] = fast_sigmoid(rs * v[3]) * bf_hi(pw.y); }
                const f32x4 o = hbuf[sc][q] + v;
                *(f32x4*)(hout + off) = o;
                if (hb) { u32x2 w; w.x = pk_bf16(o[0], o[1]); w.y = pk_bf16(o[2], o[3]); *(u32x2*)(hb + off) = w; }
                sq += (o[0] * o[0] + o[1] * o[1]) + (o[2] * o[2] + o[3] * o[3]); }
            if (ss_out) { sq += __shfl_xor(sq, 16); sq += __shfl_xor(sq, 32); if (fq == 0) atomicAdd((unsigned*)(ss_out + row), ss_enc(sq)); }
            asm volatile("" ::: "memory"); }
#undef RES_LOAD
    }
};
template <int MODE, int IN16, int OUT32> struct EpiResid16 {
    static constexpr bool PERM = true;
    const float* hin; const bf16_t* hin16; float* hout; bf16_t* hb; float* ss_out; const float* ss_in; const bf16_t* pp;
    __device__ __forceinline__ void operator()(const f32x4 (&acc)[2][2][4][2], const Unit& u, int wr, int wc, int fr, int fq) const {
        const int row0 = u.pm * BM + wr * 64 + fr, col0 = u.pn * BM + wc * 32 + 8 * fq;
        constexpr int RD = 3;
        f32x4 hbuf[RD][4]; u32x4 hraw[RD][2]; u32x4 pbuf[RD][2]; float rsb[RD];
#define RES_LOAD(S, it) do { const size_t ro_ = (size_t)(row0 + ((it) >> 2) * HALF + ((it) & 3) * 16) * DM + col0; \
        _Pragma("unroll") for (int b_ = 0; b_ < 2; ++b_) { const size_t off_ = ro_ + b_ * HALF; \
            if (IN16) hraw[S][b_] = *(const u32x4*)(hin16 + off_); else { hbuf[S][2 * b_] = *(const f32x4*)(hin + off_); hbuf[S][2 * b_ + 1] = *(const f32x4*)(hin + off_ + 4); } \
            if (MODE == 1) pbuf[S][b_] = *(const u32x4*)(pp + off_); } \
        if (MODE == 1) rsb[S] = ss_in[row0 + ((it) >> 2) * HALF + ((it) & 3) * 16]; } while (0)
        RES_LOAD(0, 0); RES_LOAD(1, 1);
#pragma unroll
        for (int it = 0; it < 8; ++it) { const int ai = it >> 2, m = it & 3, sc = it % RD;
            if (it + RD - 1 < 8) RES_LOAD((it + RD - 1) % RD, it + RD - 1);
            asm volatile("" ::: "memory");
            const int row = row0 + ai * HALF + m * 16; const size_t ro = (size_t)row * DM + col0;
            float rs = 1.0f; if (MODE == 1) rs = __builtin_amdgcn_rsqf(ss_fix(rsb[sc]) * (1.0f / DM) + EPS);
            float sq = 0.f;
#pragma unroll
            for (int bj = 0; bj < 2; ++bj) { const size_t off = ro + bj * HALF;
                f32x4 v0 = acc[ai][bj][m][0], v1 = acc[ai][bj][m][1];
                if (MODE == 1) { const u32x4 pw = pbuf[sc][bj];
                    v0[0] = fast_sigmoid(rs * v0[0]) * bf_lo(pw.x); v0[1] = fast_sigmoid(rs * v0[1]) * bf_hi(pw.x); v0[2] = fast_sigmoid(rs * v0[2]) * bf_lo(pw.y); v0[3] = fast_sigmoid(rs * v0[3]) * bf_hi(pw.y);
                    v1[0] = fast_sigmoid(rs * v1[0]) * bf_lo(pw.z); v1[1] = fast_sigmoid(rs * v1[1]) * bf_hi(pw.z); v1[2] = fast_sigmoid(rs * v1[2]) * bf_lo(pw.w); v1[3] = fast_sigmoid(rs * v1[3]) * bf_hi(pw.w); }
                f32x4 h0, h1;
                if (IN16) { const u32x4 hw = hraw[sc][bj]; h0 = (f32x4){bf_lo(hw.x), bf_hi(hw.x), bf_lo(hw.y), bf_hi(hw.y)}; h1 = (f32x4){bf_lo(hw.z), bf_hi(hw.z), bf_lo(hw.w), bf_hi(hw.w)}; }
                else { h0 = hbuf[sc][2 * bj]; h1 = hbuf[sc][2 * bj + 1]; }
                const f32x4 o0 = h0 + v0, o1 = h1 + v1;
                if (OUT32) { *(f32x4*)(hout + off) = o0; *(f32x4*)(hout + off + 4) = o1; }
                if (hb) { u32x4 w; w.x = pk_bf16(o0[0], o0[1]); w.y = pk_bf16(o0[2], o0[3]); w.z = pk_bf16(o1[0], o1[1]); w.w = pk_bf16(o1[2], o1[3]); *(u32x4*)(hb + off) = w; }
                sq += ((o0[0] * o0[0] + o0[1] * o0[1]) + (o0[2] * o0[2] + o0[3] * o0[3])) + ((o1[0] * o1[0] + o1[1] * o1[1]) + (o1[2] * o1[2] + o1[3] * o1[3])); }
            if (ss_out) { sq += __shfl_xor(sq, 16); sq += __shfl_xor(sq, 32); if (fq == 0) atomicAdd((unsigned*)(ss_out + row), ss_enc(sq)); }
            asm volatile("" ::: "memory"); }
#undef RES_LOAD
    }
};
struct EpiGates {
    static constexpr bool PERM = false;
    const bf16_t* xc; const float* b_ga; const float* b_gx; const float* lam; bf16_t* aout; bf16_t* bout;
    __device__ __forceinline__ void operator()(const f32x4 (&acc)[2][2][4][2], const Unit& u, int wr, int wc, int fr, int fq) const {
        const int row0 = u.pm * BM + wr * 64 + fr, ch0 = u.pn * HALF + wc * 32 + 4 * fq;
#pragma unroll
        for (int n = 0; n < 2; ++n) {
            const f32x4 ba = *(const f32x4*)(b_ga + ch0 + n * 16), bx = *(const f32x4*)(b_gx + ch0 + n * 16), sp = *(const f32x4*)(lam + ch0 + n * 16);
            u32x2 xall[8];
#pragma unroll
            for (int it = 0; it < 8; ++it) xall[it] = *(const u32x2*)(xc + (size_t)(row0 + (it >> 2) * HALF + (it & 3) * 16) * DM + ch0 + n * 16);
            asm volatile("" ::: "memory");
#pragma unroll
            for (int ai = 0; ai < 2; ++ai)
#pragma unroll
                for (int m = 0; m < 4; ++m) { const int row = row0 + ai * HALF + m * 16; const size_t off = (size_t)row * DM + ch0 + n * 16;
                    const u32x2 xw = xall[ai * 4 + m];
                    const float xv[4] = {bf_lo(xw.x), bf_hi(xw.x), bf_lo(xw.y), bf_hi(xw.y)};
                    f32x4 av; float bv[4];
#pragma unroll
                    for (int j = 0; j < 4; ++j) { const float r = fast_sigmoid(acc[ai][0][m][n][j] + ba[j]), ig = fast_sigmoid(acc[ai][1][m][n][j] + bx[j]);
                        const float la = sp[j] * r; const float la2 = __uint_as_float(pk_bf16(la * LOG2E, 0.f) << 16);
                        const float a = __builtin_amdgcn_exp2f(la2); const float x2 = 2.0f * la2 * 0.6931471805599453f; av[j] = la2;
                        const float om = (x2 > -0.03f) ? -(x2 * (1.0f + x2 * (0.5f + x2 * (1.0f / 6.0f + x2 * (1.0f / 24.0f))))) : (1.0f - a * a);
                        bv[j] = __builtin_amdgcn_sqrtf(om) * (ig * xv[j]); }
                    { u32x2 wa; wa.x = pk_bf16(av[0], av[1]); wa.y = pk_bf16(av[2], av[3]); *(u32x2*)(aout + off) = wa; }
                    u32x2 w; w.x = pk_bf16(bv[0], bv[1]); w.y = pk_bf16(bv[2], bv[3]); *(u32x2*)(bout + off) = w; }
        }
    }
};
}

__device__ __forceinline__ void conv_transpose(LAS unsigned char* lds, const float* src, int ld, int K, int N, bf16_t* dst, int ldd, const float* gain, int G, int c, int wv) {
    LAS bf16_t* tile = (LAS bf16_t*)lds;
    const int tid = opaque_tid(wv);
    const int nsub = (N & 255) ? 2 : 4, nw = 64 * nsub;
    const int ntk = K / 64, ntn = N / nw, ntl = ntk * ntn;
    f32x4 v[4][2], vn[4][2]; float g0 = 1.f, g1 = 1.f, gn0 = 1.f, gn1 = 1.f;
#define CT_LOAD(V, GA, GB, t_) do { const int tk_ = (t_) % ntk, tn_ = (t_) / ntk, k0_ = tk_ * 64, n0_ = tn_ * nw; \
        _Pragma("unroll") for (int s = 0; s < 4; ++s) if (s < nsub) { _Pragma("unroll") for (int i = 0; i < 2; ++i) { const int kk = (tid >> 4) + 32 * i; V[s][i] = __builtin_nontemporal_load((const f32x4*)(src + (size_t)(k0_ + kk) * ld + n0_ + s * 64 + (tid & 15) * 4)); } } \
        if (gain) { GA = gain[k0_ + (tid >> 4)]; GB = gain[k0_ + (tid >> 4) + 32]; } } while (0)
    if (c < ntl) CT_LOAD(v, g0, g1, c);
    for (int t = c; t < ntl; t += G) {
        const int tk = t % ntk, tn = t / ntk, k0 = tk * 64, n0 = tn * nw;
        if (t + G < ntl) CT_LOAD(vn, gn0, gn1, t + G);
#pragma unroll
        for (int s = 0; s < 4; ++s) if (s < nsub) {
#pragma unroll
            for (int i = 0; i < 2; ++i) { const int kk = (tid >> 4) + 32 * i; const f32x4 w = v[s][i] * (i ? g1 : g0);
#pragma unroll
                for (int j = 0; j < 4; ++j) tile[s * 4224 + ((tid & 15) * 4 + j) * 66 + kk] = (bf16_t)(pk_bf16(w[j], 0.f) & 0xffffu); } }
        __syncthreads();
#pragma unroll
        for (int s = 0; s < 4; ++s) if (s < nsub) {
            const int n = tid >> 3, k8 = (tid & 7) * 8; const LAS unsigned* tp = (const LAS unsigned*)(tile + s * 4224 + n * 66 + k8);
            u32x4 w; w.x = tp[0]; w.y = tp[1]; w.z = tp[2]; w.w = tp[3];
            *(u32x4*)(dst + (size_t)(n0 + s * 64 + n) * ldd + k0 + k8) = w; }
        __syncthreads();
#pragma unroll
        for (int s = 0; s < 4; ++s) { v[s][0] = vn[s][0]; v[s][1] = vn[s][1]; } g0 = gn0; g1 = gn1;
    }
#undef CT_LOAD
}

struct Params {
    const float* in[27];
    float* out;
    unsigned char* ws;
};
#define CAS __attribute__((address_space(4)))
struct KArgs {
    __device__ __forceinline__ const CAS char* base() const { const CAS char* ka = (const CAS char*)__builtin_amdgcn_kernarg_segment_ptr(); asm volatile("" : "+s"(ka)); return ka; }
    __device__ __forceinline__ const float* in(int i) const { return *(const float* const CAS*)(base() + 8 * i); }
    __device__ __forceinline__ float* out() const { return *(float* const CAS*)(base() + 8 * 27); }
    __device__ __forceinline__ unsigned char* ws() const { return *(unsigned char* const CAS*)(base() + 8 * 28); }
};
enum { I_X = 0, I_P, I_GMIX, I_GMLP, I_GPLE, I_WQKV, I_GQ, I_GK, I_LQ1, I_LK1, I_LQ2, I_LK2, I_GSUB, I_WOA, I_WIN, I_CONVW, I_CONVB, I_WGA, I_BGA, I_WGX, I_BGX, I_LAMR, I_WOR, I_WUP, I_WDN, I_WPP, I_WPG };

__device__ __forceinline__ void prep_layer(LAS unsigned char* lds, const KArgs& P, int layer, int G, int c, int wv) {
    unsigned char* W = P.ws() + WS_W;
    if (layer == 0) {
        conv_transpose(lds, P.in(I_WQKV), 6144, 2048, 4096, (bf16_t*)(W + W_A), 2048, P.in(I_GMIX), G, c, wv);
        conv_transpose(lds, P.in(I_WQKV) + 4096, 6144, 2048, 2048, (bf16_t*)(W + W_B), 2048, P.in(I_GMIX), G, c, wv);
        conv_transpose(lds, P.in(I_WOA), 2048, 2048, 2048, (bf16_t*)(W + W_O), 2048, nullptr, G, c, wv);
    } else {
        conv_transpose(lds, P.in(I_WIN), 4096, 2048, 4096, (bf16_t*)(W + W_A), 2048, P.in(I_GMIX) + DM, G, c, wv);
        for (int j = 0; j < 32; ++j) { const int nb = j >> 2, gate = (j >> 1) & 1, half = j & 1;
            const float* src = (gate ? P.in(I_WGX) : P.in(I_WGA)) + (size_t)nb * 65536 + half * 128;
            bf16_t* dst = (bf16_t*)(W + W_B) + (size_t)((2 * nb + half) * 256 + gate * 128) * 256;
            conv_transpose(lds, src, 256, 256, 128, dst, 256, nullptr, G, (c + j * 8) % G, wv); }
        conv_transpose(lds, P.in(I_WOR), 2048, 2048, 2048, (bf16_t*)(W + W_O), 2048, nullptr, G, c, wv);
        if (c == 0) { float* spt = (float*)(P.ws() + WS_SP); const float* lr = P.in(I_LAMR); for (int i = opaque_tid(wv); i < DM; i += NT) spt[i] = -8.0f * log1pf(__expf(-lr[i])); }
    }
    conv_transpose(lds, P.in(I_WUP) + (size_t)layer * DM * DFF, DFF, DM, DFF, (bf16_t*)(W + W_UP), DM, P.in(I_GMLP) + layer * DM, G, c, wv);
    conv_transpose(lds, P.in(I_WDN) + (size_t)layer * DM * DFF, DM, DFF, DM, (bf16_t*)(W + W_DN), DFF, nullptr, G, c, wv);
    conv_transpose(lds, P.in(I_WPG) + (size_t)layer * DM * DM, DM, DM, DM, (bf16_t*)(W + W_PG), DM, P.in(I_GPLE) + layer * DM, G, c, wv);
    conv_transpose(lds, P.in(I_WPP) + (size_t)layer * DPLE * DM, DM, DPLE, DM, (bf16_t*)(W + W_PP), DPLE, nullptr, G, c, wv);
    const float* p = P.in(I_P) + (size_t)layer * MTOK * DPLE; bf16_t* pb = (bf16_t*)(P.ws() + WS_PB);
    for (size_t i = ((size_t)c * NT + opaque_tid(wv)) * 4; i < (size_t)MTOK * DPLE; i += (size_t)G * NT * 4) { const f32x4 v = __builtin_nontemporal_load((const f32x4*)(p + i)); u32x2 w; w.x = pk_bf16(v[0], v[1]); w.y = pk_bf16(v[2], v[3]); *(u32x2*)(pb + i) = w; }
}

__device__ __forceinline__ void prep_x(const KArgs& P, int G, int c, int wv) {
    const float* x = P.in(I_X); bf16_t* hb = (bf16_t*)(P.ws() + WS_HBA); float* ss = (float*)(P.ws() + WS_SS);
    const int tid0 = opaque_tid(wv), wid = tid0 >> 6, lane = tid0 & 63;
    for (int row = c * 8 + wid; row < MTOK; row += G * 8) {
        float sq = 0.f;
#pragma unroll
        for (int i = 0; i < 8; ++i) { const size_t off = (size_t)row * DM + i * 256 + lane * 4; const f32x4 v = *(const f32x4*)(x + off);
            sq += (v[0] * v[0] + v[1] * v[1]) + (v[2] * v[2] + v[3] * v[3]); u32x2 w; w.x = pk_bf16(v[0], v[1]); w.y = pk_bf16(v[2], v[3]); *(u32x2*)(hb + off) = w; }
#pragma unroll
        for (int o = 32; o >= 1; o >>= 1) sq += __shfl_xor(sq, o);
        if (lane == 0) ss[row] = __uint_as_float(ss_enc(sq));
    }
    for (int i = c * NT + tid0; i < 5 * MTOK; i += G * NT) ss[MTOK + i] = 0.f;
}

__device__ __forceinline__ void qknorm_phase(const KArgs& P, int G, int c, int wv) {
    bf16_t* qk = (bf16_t*)(P.ws() + WS_T + T_QK);
    const int tid = opaque_tid(wv), chunk = tid >> 4, d8 = (tid & 15) * 8; const bool isq = chunk < 16;
    const float* gp = (isq ? P.in(I_GQ) : P.in(I_GK)) + d8; float g[8];
    const float qs = isq ? 0.08838834764831845f * LOG2E : 1.0f;
#pragma unroll
    for (int j = 0; j < 8; ++j) g[j] = gp[j] * qs;
    for (int row = c; row < MTOK; row += G) {
        u32x4* ptr = (u32x4*)(qk + (size_t)row * 4096 + chunk * 128 + d8); const u32x4 w = *ptr;
        float v[8] = {bf_lo(w.x), bf_hi(w.x), bf_lo(w.y), bf_hi(w.y), bf_lo(w.z), bf_hi(w.z), bf_lo(w.w), bf_hi(w.w)};
        float sq = 0.f;
#pragma unroll
        for (int j = 0; j < 8; ++j) sq += v[j] * v[j];
        sq += __shfl_xor(sq, 1); sq += __shfl_xor(sq, 2); sq += __shfl_xor(sq, 4); sq += __shfl_xor(sq, 8);
        const float rs = __builtin_amdgcn_rsqf(sq * (1.0f / 128.0f) + EPS);
        u32x4 o; o.x = pk_bf16(v[0] * rs * g[0], v[1] * rs * g[1]); o.y = pk_bf16(v[2] * rs * g[2], v[3] * rs * g[3]); o.z = pk_bf16(v[4] * rs * g[4], v[5] * rs * g[5]); o.w = pk_bf16(v[6] * rs * g[6], v[7] * rs * g[7]);
        *ptr = o;
    }
}

#define MFMA32(a, b, c) __builtin_amdgcn_mfma_f32_32x32x16_bf16((a), (b), (c), 0, 0, 0)
__device__ __forceinline__ float uniform_f(float v) { return __int_as_float(__builtin_amdgcn_readfirstlane(__float_as_int(v))); }
__device__ __forceinline__ void attn_stage(LAS unsigned char* lds, int buf, const bf16_t* kbase, const bf16_t* vbase, int k0, int wid, int lane) {
    if (wid < 4) {
        const int sub = wid >> 1;
#pragma unroll
        for (int j = 0; j < 8; ++j) {
            const int pi = wid * 8 + j, row = (pi & 15) * 4 + (lane >> 4), gch = (lane & 15) ^ (row & 15);
            const bf16_t* src = kbase + (size_t)(k0 + row) * 4096 + sub * 128 + gch * 8;
            __builtin_amdgcn_global_load_lds((const unsigned*)src, (LAS unsigned*)(lds + buf * 65536 + pi * 1024), 16, 0, 0);
        }
    } else {
#pragma unroll
        for (int j = 0; j < 8; ++j) {
            const int pi = wid * 8 + j, row = (pi - 32) * 8 + (lane >> 3), gch = (lane & 7) ^ ((row >> 1) & 7);
            const bf16_t* src = vbase + (size_t)row * MTOK + k0 + gch * 8;
            __builtin_amdgcn_global_load_lds((const unsigned*)src, (LAS unsigned*)(lds + buf * 65536 + pi * 1024), 16, 0, 0);
        }
    }
}

__device__ __forceinline__ void attn_phase(LAS unsigned char* lds, const KArgs& P, int G, int c, int wv) {
    const bf16_t* qk = (const bf16_t*)(P.ws() + WS_T + T_QK); const bf16_t* vT = (const bf16_t*)(P.ws() + WS_T + T_VT); bf16_t* og = (bf16_t*)(P.ws() + WS_T + T_O);
    const int tid = opaque_tid(wv), wid = __builtin_amdgcn_readfirstlane(tid >> 6), lane = tid & 63, r = lane & 31, hh = lane >> 5;
    const int sub = wid >> 2, wq = wid & 3;
    float lamv, Mb;
    { const float* gq = P.in(I_GQ); const float* gk = P.in(I_GK);
      float d1 = P.in(I_LQ1)[lane] * P.in(I_LK1)[lane] + P.in(I_LQ1)[lane + 64] * P.in(I_LK1)[lane + 64];
      float d2 = P.in(I_LQ2)[lane] * P.in(I_LK2)[lane] + P.in(I_LQ2)[lane + 64] * P.in(I_LK2)[lane + 64];
      float mq = fmaxf(fabsf(gq[lane]), fabsf(gq[lane + 64])), mk = fmaxf(fabsf(gk[lane]), fabsf(gk[lane + 64]));
#pragma unroll
      for (int o = 32; o >= 1; o >>= 1) { d1 += __shfl_xor(d1, o); d2 += __shfl_xor(d2, o); mq = fmaxf(mq, __shfl_xor(mq, o)); mk = fmaxf(mk, __shfl_xor(mk, o)); }
      lamv = uniform_f(__expf(d1) - __expf(d2) + 0.2f);
      Mb = uniform_f(11.313708498984761f * LOG2E * mq * mk * 1.01f + 0.5f); }
    const int pr = (r & 19) | ((r & 4) << 1) | ((r & 8) >> 1);
    if (sub == 0) __builtin_amdgcn_s_setprio(1); else __builtin_amdgcn_s_setprio(0);
    unsigned* qctr = (unsigned*)(P.ws() + WS_QCTR);
    volatile LAS unsigned* qslot = (volatile LAS unsigned*)(lds + 131072 + 16);
    if (tid == 0) { qslot[1] = (unsigned)__builtin_amdgcn_s_getreg((3 << 11) | 20) & 7u; qslot[2] = 0u; }
    for (;;) {
        if (tid == 0) { unsigned u; unsigned qcur = qslot[1], qhops = qslot[2];
            for (;;) { u = atomicAdd(qctr + qcur * 16, 1u); if (u < 128u || qhops == 7u) break; ++qhops; qcur = (qcur + 1u) & 7u; }
            qslot[1] = qcur; qslot[2] = qhops;
            *qslot = (u < 128u) ? qcur * 128u + u : 0xffffffffu; }
        __syncthreads();
        const unsigned code = *qslot;
        if (code == 0xffffffffu) break;
        const int qx = (int)(code >> 7), u = (int)(code & 127u), hsel = u >> 5, qb = 31 - (u & 31);
        const int hd = (qx & 1) ? (hsel == 0 ? 6 : hsel == 1 ? 5 : hsel == 2 ? 2 : 1) : (hsel == 0 ? 7 : hsel == 1 ? 4 : hsel == 2 ? 3 : 0);
        const int bh = (qx >> 1) * 8 + hd;
        const int b = bh >> 3, h = bh & 7;
        int lq = lane; asm volatile("" : "+v"(lq));
        const int q0 = qb * 128, qw = q0 + wq * 32, myq = qw + (lq & 31);
        const size_t tok0 = (size_t)b * SEQ;
        const bf16_t* kbase = qk + tok0 * 4096 + 2048 + h * 256;
        const bf16_t* vbase = vT + (size_t)(h * 256) * MTOK + tok0;
        bf16x8 qf[8];
        { const bf16_t* qp = qk + (tok0 + myq) * 4096 + h * 256 + sub * 128 + (lq >> 5) * 8;
#pragma unroll
          for (int ks = 0; ks < 8; ++ks) qf[ks] = *(const bf16x8*)(qp + ks * 16); }
        f32x16 O[8];
#pragma unroll
        for (int d = 0; d < 8; ++d)
#pragma unroll
            for (int i = 0; i < 16; ++i) O[d][i] = 0.f;
        float lsum = 0.f;
        const float sl2 = uniform_f(__builtin_amdgcn_exp2f(-(float)(h + 1)) * LOG2E);
        const int nkt = 2 * qb + 2;
        int kt0 = 0; { const float dmax = 160.0f / sl2; const int kmin = q0 - 63 - (int)dmax; if (kmin > 0) kt0 = (kmin + 63) >> 6; if (kt0 > nkt - 1) kt0 = nkt - 1; }
        { int lz0 = lane; asm volatile("" : "+v"(lz0)); attn_stage(lds, kt0 & 1, kbase, vbase, kt0 * 64, wid, lz0); }
        for (int kt = kt0; kt < nkt; ++kt) {
            asm volatile("s_waitcnt vmcnt(0)" ::: "memory");
            __syncthreads();
            int lz = lane; asm volatile("" : "+v"(lz));
            if (kt + 1 < nkt) attn_stage(lds, (kt + 1) & 1, kbase, vbase, (kt + 1) * 64, wid, lz);
            const int k0 = kt * 64;
            if (k0 <= qw + 31) {
                const int rz = lz & 31, hz = lz >> 5, prz = (rz & 19) | ((rz & 4) << 1) | ((rz & 8) >> 1);
                const LAS unsigned char* kb = lds + (kt & 1) * 65536 + sub * 16384 + prz * 256;
                const int kx = (hz ^ (prz & 15)) * 16;
                const LAS unsigned char* vb = lds + (kt & 1) * 65536 + 32768 + rz * 128;
                const int vx = (hz ^ ((rz >> 1) & 7)) * 16;
                const int rel0 = k0 + 8 * hz - (qw + rz);
                const float tb = sl2 * (float)rel0 - Mb;
                const bool diag = (k0 + 63 > qw);
#pragma unroll
                for (int half = 0; half < 2; ++half) {
#define KREAD(ks_) (*(const LAS bf16x8*)(kb + half * 8192 + ((32 * (ks_)) ^ kx)))
#define VREAD(i_) (*(const LAS bf16x8*)(vb + ((i_) >> 1) * 4096 + (((4 * half + 2 * ((i_) & 1)) * 16) ^ vx)))
                    f32x16 s;
#pragma unroll
                    for (int i = 0; i < 16; ++i) s[i] = 0.f;
                    bf16x8 fr4[2];
                    fr4[0] = KREAD(0);
                    __builtin_amdgcn_sched_barrier(0);
#pragma unroll
                    for (int ks = 0; ks < 8; ++ks) {
                        if (ks + 1 < 8) fr4[(ks + 1) & 1] = KREAD(ks + 1);
                        s = MFMA32(fr4[ks & 1], qf[ks], s);
                        __builtin_amdgcn_sched_barrier(0);
                    }
                    bf16x8 pf0, pf1;
                    { float pv[8];
#pragma unroll
                      for (int j = 0; j < 8; ++j) { const int cc = 32 * half + j;
                          float p = __builtin_amdgcn_exp2f(s[j] + (tb + sl2 * (float)cc));
                          if (diag && (rel0 + cc > 0)) p = 0.f;
                          pv[j] = p; lsum += p; }
                      u32x4 w; w.x = pk_bf16(pv[0], pv[1]); w.y = pk_bf16(pv[2], pv[3]); w.z = pk_bf16(pv[4], pv[5]); w.w = pk_bf16(pv[6], pv[7]);
                      pf0 = __builtin_bit_cast(bf16x8, w); }
                    __builtin_amdgcn_sched_barrier(0);
                    u32x4 w1; float pe = 0.f;
#pragma unroll
                    for (int d = 0; d < 8; ++d) {
                        O[d] = MFMA32(VREAD(2 * d), pf0, O[d]);
                        { const int cc = 32 * half + 16 + d;
                          float p = __builtin_amdgcn_exp2f(s[8 + d] + (tb + sl2 * (float)cc));
                          if (diag && (rel0 + cc > 0)) p = 0.f;
                          lsum += p;
                          if (d & 1) w1[d >> 1] = pk_bf16(pe, p); else pe = p; }
                        __builtin_amdgcn_sched_barrier(0);
                    }
                    pf1 = __builtin_bit_cast(bf16x8, w1);
#pragma unroll
                    for (int d = 0; d < 8; ++d) {
                        O[d] = MFMA32(VREAD(2 * d + 1), pf1, O[d]);
                        __builtin_amdgcn_sched_barrier(0);
                    }
#undef KREAD
#undef VREAD
                }
            }
        }
        __syncthreads();
        const float ltot = lsum + __shfl_xor(lsum, 32);
        const float inv = 1.0f / ltot;
        int le = lane; asm volatile("" : "+v"(le));
        LAS float* cb0 = (LAS float*)lds + wq * 64 + le; LAS float* cb1 = cb0 + 16384;
        asm volatile("" : "+v"(cb0), "+v"(cb1));
        if (sub == 1) {
#pragma unroll
            for (int d = 0; d < 8; ++d)
#pragma unroll
                for (int i = 0; i < 16; ++i) (d < 4 ? cb0 : cb1)[(((d & 3) * 16 + i) * 4) * 64] = O[d][i] * inv;
        }
        __syncthreads();
        if (sub == 0) {
            float sq = 0.f;
#pragma unroll
            for (int d = 0; d < 8; ++d)
#pragma unroll
                for (int i = 0; i < 16; ++i) { const float v = O[d][i] * inv - lamv * (d < 4 ? cb0 : cb1)[(((d & 3) * 16 + i) * 4) * 64]; O[d][i] = v; sq += v * v; }
            sq += __shfl_xor(sq, 32);
            const float rs = __builtin_amdgcn_rsqf(sq * (1.0f / 256.0f) + EPS) * 0.8f;
            bf16_t* orow = og + (tok0 + qw + (le & 31)) * DM + h * 256;
            const float* gs = P.in(I_GSUB); asm volatile("" : "+s"(gs));
#pragma unroll
            for (int d = 0; d < 8; ++d)
#pragma unroll
                for (int g4 = 0; g4 < 4; ++g4) { const int dv = 32 * d + 8 * g4 + 4 * (le >> 5); const f32x4 gv = *(const f32x4*)(gs + dv);
                    u32x2 w; w.x = pk_bf16(O[d][4 * g4] * rs * gv[0], O[d][4 * g4 + 1] * rs * gv[1]); w.y = pk_bf16(O[d][4 * g4 + 2] * rs * gv[2], O[d][4 * g4 + 3] * rs * gv[3]);
                    *(u32x2*)(orow + dv) = w; }
        }
        __syncthreads();
    }
    __builtin_amdgcn_s_setprio(0);
}

__device__ __forceinline__ void conv_phase(const KArgs& P, int G, int c, int wv) {
    const bf16_t* xr = (const bf16_t*)(P.ws() + WS_T + T_XR); bf16_t* xc = (bf16_t*)(P.ws() + WS_HBA);
    const float* cw = P.in(I_CONVW); const float* cbias = P.in(I_CONVB);
    const int tid = opaque_tid(wv), c8 = (tid & 255) * 8, rsel = tid >> 8;
    float w[4][8], bb[8];
#pragma unroll
    for (int j = 0; j < 8; ++j) { bb[j] = cbias[c8 + j];
#pragma unroll
        for (int k = 0; k < 4; ++k) w[k][j] = cw[k * DM + c8 + j]; }
    for (int row = c * 2 + rsel; row < MTOK; row += G * 2) {
        const int t = row & (SEQ - 1);
        float acc[8];
#pragma unroll
        for (int j = 0; j < 8; ++j) acc[j] = bb[j];
#pragma unroll
        for (int k = 0; k < 4; ++k) { const int dt = 3 - k; if (t >= dt) { const u32x4 v = *(const u32x4*)(xr + (size_t)(row - dt) * DM + c8);
            const float f[8] = {bf_lo(v.x), bf_hi(v.x), bf_lo(v.y), bf_hi(v.y), bf_lo(v.z), bf_hi(v.z), bf_lo(v.w), bf_hi(v.w)};
#pragma unroll
            for (int j = 0; j < 8; ++j) acc[j] += w[k][j] * f[j]; } }
        u32x4 o; o.x = pk_bf16(acc[0], acc[1]); o.y = pk_bf16(acc[2], acc[3]); o.z = pk_bf16(acc[4], acc[5]); o.w = pk_bf16(acc[6], acc[7]);
        *(u32x4*)(xc + (size_t)row * DM + c8) = o;
    }
}
constexpr int CHK = 64, NCHK = SEQ / CHK;
__device__ __forceinline__ void scan_a_phase(const KArgs& P, int G, int c, int wv) {
    const bf16_t* A = (const bf16_t*)(P.ws() + WS_T + T_A); const bf16_t* Bq = (const bf16_t*)(P.ws() + WS_T + T_BQ);
    float* PS = (float*)(P.ws() + WS_T + T_PS); float* HS = PS + 4 * NCHK * DM;
    for (int item = c * NT + opaque_tid(wv); item < 4 * NCHK * (DM / 4); item += G * NT) {
        const int c4 = item & (DM / 4 - 1), ck = (item >> 9) & (NCHK - 1), b = item >> 15;
        const size_t base = ((size_t)b * SEQ + ck * CHK) * DM + c4 * 4;
        f32x4 pa = {1.f, 1.f, 1.f, 1.f}, hv = {0.f, 0.f, 0.f, 0.f};
#pragma unroll 8
        for (int t = 0; t < CHK; ++t) { const u32x2 aw = *(const u32x2*)(A + base + (size_t)t * DM); const u32x2 bw = *(const u32x2*)(Bq + base + (size_t)t * DM);
            const f32x4 a = {__builtin_amdgcn_exp2f(bf_lo(aw.x)), __builtin_amdgcn_exp2f(bf_hi(aw.x)), __builtin_amdgcn_exp2f(bf_lo(aw.y)), __builtin_amdgcn_exp2f(bf_hi(aw.y))};
            const f32x4 bq = {bf_lo(bw.x), bf_hi(bw.x), bf_lo(bw.y), bf_hi(bw.y)}; pa *= a; hv = a * hv + bq; }
        const size_t si = (size_t)(b * NCHK + ck) * DM + c4 * 4;
        *(f32x4*)(PS + si) = pa; *(f32x4*)(HS + si) = hv;
    }
}
__device__ __forceinline__ void scan_b_phase(const KArgs& P, int G, int c, int wv) {
    const bf16_t* A = (const bf16_t*)(P.ws() + WS_T + T_A); const bf16_t* Bq = (const bf16_t*)(P.ws() + WS_T + T_BQ); bf16_t* Y = (bf16_t*)(P.ws() + WS_T + T_Y);
    const float* PS = (const float*)(P.ws() + WS_T + T_PS); const float* HS = PS + 4 * NCHK * DM;
    for (int item = c * NT + opaque_tid(wv); item < 4 * NCHK * (DM / 4); item += G * NT) {
        const int c4 = item & (DM / 4 - 1), ck = (item >> 9) & (NCHK - 1), b = item >> 15;
        f32x4 hv = {0.f, 0.f, 0.f, 0.f};
#pragma unroll 8
        for (int j = 0; j < ck; ++j) { const size_t si = (size_t)(b * NCHK + j) * DM + c4 * 4; hv = *(const f32x4*)(PS + si) * hv + *(const f32x4*)(HS + si); }
        const size_t base = ((size_t)b * SEQ + ck * CHK) * DM + c4 * 4;
#pragma unroll 8
        for (int t = 0; t < CHK; ++t) { const size_t o = base + (size_t)t * DM; const u32x2 aw = *(const u32x2*)(A + o); const f32x4 a = {__builtin_amdgcn_exp2f(bf_lo(aw.x)), __builtin_amdgcn_exp2f(bf_hi(aw.x)), __builtin_amdgcn_exp2f(bf_lo(aw.y)), __builtin_amdgcn_exp2f(bf_hi(aw.y))}; const u32x2 bw = *(const u32x2*)(Bq + o); const u32x2 yw = *(const u32x2*)(Y + o);
            const f32x4 bq = {bf_lo(bw.x), bf_hi(bw.x), bf_lo(bw.y), bf_hi(bw.y)}; hv = a * hv + bq;
            u32x2 ow; ow.x = pk_bf16(hv[0] * bf_lo(yw.x), hv[1] * bf_hi(yw.x)); ow.y = pk_bf16(hv[2] * bf_lo(yw.y), hv[3] * bf_hi(yw.y)); *(u32x2*)(Y + o) = ow; }
    }
}

#define XB_TMO      128
#define XB_XCNT(j)  (256  + 64 * (j))
#define XB_XSUB(j)  (1280 + 64 * (j))
#define XB_XGEN(j)  (2304 + 64 * (j))
#define XB_TOP      3328
#define XB_TOPGEN   3392
#define XCD_BAR_WORDS 3456
#define XB_SPIN_CAP (1u << 18)
__device__ __forceinline__ unsigned xb_ld(unsigned* p)              { return __hip_atomic_load(p, __ATOMIC_RELAXED, __HIP_MEMORY_SCOPE_AGENT); }
__device__ __forceinline__ unsigned xb_add(unsigned* p, unsigned v) { return __hip_atomic_fetch_add(p, v, __ATOMIC_RELAXED, __HIP_MEMORY_SCOPE_AGENT); }
__device__ __forceinline__ unsigned xb_xcc_id() { return (unsigned)__builtin_amdgcn_s_getreg((3 << 11) | 20) & 0xFu; }
#define XB_SPIN(cond, bar) do { unsigned _sp = 0; while (cond) { __builtin_amdgcn_s_sleep(1); \
    if ((++_sp & 255u) == 0u) { if (xb_ld(&(bar)[XB_TMO])) break; if (_sp > XB_SPIN_CAP) { atomicAdd(&(bar)[XB_TMO], 1u); break; } } } } while (0)
struct XcdBarrier { unsigned* bar; unsigned x; volatile LAS unsigned* st; int wv; };
__device__ __forceinline__ XcdBarrier xcd_barrier_post(unsigned* bar, volatile LAS unsigned* st) {
    XcdBarrier b; b.bar = bar; b.x = xb_xcc_id(); b.st = st; b.wv = 0;
    if (threadIdx.x == 0) (void)xb_add(&bar[XB_XCNT(b.x)], 1u);
    return b;
}
__device__ __forceinline__ void xcd_barrier_complete(unsigned* bar, unsigned x, unsigned& nloc, unsigned& nx) {
    const unsigned G = gridDim.x * gridDim.y * gridDim.z;
    unsigned sum, cnt, mine, sp = 0u;
    for (;;) {
        sum = 0u; cnt = 0u; mine = 0u;
#pragma unroll
        for (unsigned j = 0; j < 16; ++j) { const unsigned c = xb_ld(&bar[XB_XCNT(j)]); sum += c; cnt += (c > 0u) ? 1u : 0u; mine = (j == x) ? c : mine; }
        if (sum == G) break;
        __builtin_amdgcn_s_sleep(1);
        if ((++sp & 255u) == 0u) { if (xb_ld(&bar[XB_TMO])) break; if (sp > XB_SPIN_CAP) { atomicAdd(&bar[XB_TMO], 1u); break; } }
    }
    nloc = mine > 0u ? mine : 1u; nx = cnt > 0u ? cnt : 1u;
}
__device__ __forceinline__ void xcd_barrier(const XcdBarrier& b) {
    asm volatile("s_waitcnt vmcnt(0)" ::: "memory");
    __syncthreads();
    if (b.wv == 0 && __builtin_amdgcn_mbcnt_hi(~0u, __builtin_amdgcn_mbcnt_lo(~0u, 0u)) == 0u) {
        unsigned* bar = b.bar;
        __builtin_amdgcn_s_waitcnt(0);
        unsigned nloc = b.st[0], nx = b.st[1];
        if (nloc == 0u) { xcd_barrier_complete(bar, b.x, nloc, nx); b.st[0] = nloc; b.st[1] = nx; }
        const unsigned old = xb_add(&bar[XB_XSUB(b.x)], 1u);
        const unsigned gen = old / nloc;
        if (old + 1u == (gen + 1u) * nloc) {
            __builtin_amdgcn_fence(__ATOMIC_RELEASE, "agent");
            asm volatile("s_waitcnt vmcnt(0)" ::: "memory");
            const unsigned og = xb_add(&bar[XB_TOP], 1u);
            const unsigned tg = og / nx;
            if (og + 1u == (tg + 1u) * nx) xb_add(&bar[XB_TOPGEN], 1u);
            else XB_SPIN(xb_ld(&bar[XB_TOPGEN]) == tg, bar);
            __builtin_amdgcn_fence(__ATOMIC_ACQUIRE, "agent");
            xb_add(&bar[XB_XGEN(b.x)], 1u);
            asm volatile("s_waitcnt vmcnt(0)" ::: "memory");
        } else {
            XB_SPIN(xb_ld(&bar[XB_XGEN(b.x)]) == gen, bar);
            __builtin_amdgcn_fence(__ATOMIC_ACQUIRE, "agent");
            asm volatile("s_waitcnt vmcnt(0)" ::: "memory");
        }
    }
    __syncthreads();
}

#define WSB(off) ((bf16_t*)(P.ws() + (off)))
#define WSF(off) ((float*)(P.ws() + (off)))
template <int layer>
__device__ __forceinline__ void layer_tail(LAS unsigned char* lds, const KArgs& P, const XcdBarrier& xb, int G, int c, int wv) {
    pg8::StaticOrder S;
    {
        const size_t ssm = WS_SS + (size_t)(layer * 3 + 1) * MTOK * 4;
        const size_t ssf = ssm + MTOK * 4;
        const size_t ssp = ssf + MTOK * 4;
        if constexpr (layer == 1) {
            prep_layer(lds, P, 1, G, c, wv);
            xcd_barrier(xb);
            { pg8::Gemm g{WSB(WS_HBB), WSB(WS_W + W_A), DM, DM, DM, 0}; S.init(MTOK, 4096, G, c, wv);
              pg8::EpiBf16<2, 1> E{WSB(WS_T + T_Y), DM, WSF(WS_SS) + 3 * MTOK, 2048, (size_t)(T_XR - T_Y) / 2}; pg8::gemm_phase(lds, g, S, E, wv); }
            xcd_barrier(xb);
            conv_phase(P, G, c, wv);
            xcd_barrier(xb);
            { pg8::Gemm g{WSB(WS_HBA), WSB(WS_W + W_B), DM, 256, 256, 1}; S.init(MTOK, 4096, G, c, wv);
              pg8::EpiGates E{WSB(WS_HBA), P.in(I_BGA), P.in(I_BGX), WSF(WS_SP), WSB(WS_T + T_A), WSB(WS_T + T_BQ)}; pg8::gemm_phase(lds, g, S, E, wv); }
            xcd_barrier(xb);
            scan_a_phase(P, G, c, wv);
            xcd_barrier(xb);
            scan_b_phase(P, G, c, wv);
            xcd_barrier(xb);
        }
        { pg8::Gemm g{WSB(WS_T + (layer == 0 ? T_O : T_Y)), WSB(WS_W + W_O), DM, DM, DM, 0}; S.init(MTOK, DM, G, c, wv);
#if RESID_BF16
          if constexpr (layer == 0) { pg8::EpiResid16<0, 1, 0> E{nullptr, WSB(WS_HBA), nullptr, WSB(WS_HBB), WSF(ssm), nullptr, nullptr}; pg8::gemm_phase(lds, g, S, E, wv); }
          else { pg8::EpiResid16<0, 1, 0> E{nullptr, WSB(WS_HBB), nullptr, WSB(WS_HBB), WSF(ssm), nullptr, nullptr}; pg8::gemm_phase(lds, g, S, E, wv); }
#else
          pg8::EpiResid<0> E{layer == 0 ? P.in(I_X) : (const float*)P.out(), P.out(), WSB(WS_HBB), WSF(ssm), nullptr, nullptr}; pg8::gemm_phase(lds, g, S, E, wv);
#endif
        }
        xcd_barrier(xb);
        { pg8::Gemm g{WSB(WS_HBB), WSB(WS_W + W_UP), DM, DM, DM, 0}; S.init(MTOK, DFF, G, c, wv);
          pg8::EpiBf16<1, 1> E{WSB(WS_T + T_U), DFF, WSF(ssm), 0, 0}; pg8::gemm_phase(lds, g, S, E, wv);
        }
        xcd_barrier(xb);
        { pg8::Gemm g{WSB(WS_T + T_U), WSB(WS_W + W_DN), DFF, DFF, DFF, 2}; S.init(MTOK, DM, G, c, wv);
#if RESID_BF16
          pg8::EpiResid16<0, 1, 0> E{nullptr, WSB(WS_HBB), nullptr, WSB(WS_HBA), WSF(ssf), nullptr, nullptr}; pg8::gemm_phase(lds, g, S, E, wv);
#else
          pg8::EpiResid<0> E{P.out(), P.out(), WSB(WS_HBA), WSF(ssf), nullptr, nullptr}; pg8::gemm_phase(lds, g, S, E, wv);
#endif
        }
        { pg8::Gemm g{WSB(WS_PB), WSB(WS_W + W_PP), DPLE, DPLE, DPLE, 0}; S.init(MTOK, DM, G, c, wv);
          pg8::EpiBf16<0, 0> E{WSB(WS_T + T_PP), DM, nullptr, 0, 0}; pg8::gemm_phase(lds, g, S, E, wv); }
        xcd_barrier(xb);
        { pg8::Gemm g{WSB(WS_HBA), WSB(WS_W + W_PG), DM, DM, DM, 0}; S.init(MTOK, DM, G, c, wv);
#if RESID_BF16
          if constexpr (layer == 0) { pg8::EpiResid16<1, 1, 0> E{nullptr, WSB(WS_HBA), nullptr, WSB(WS_HBB), WSF(ssp), WSF(ssf), WSB(WS_T + T_PP)}; pg8::gemm_phase(lds, g, S, E, wv); }
          else { pg8::EpiResid16<1, 1, 1> E{nullptr, WSB(WS_HBA), P.out(), nullptr, nullptr, WSF(ssf), WSB(WS_T + T_PP)}; pg8::gemm_phase(lds, g, S, E, wv); }
#else
          pg8::EpiResid<1> E{P.out(), P.out(), layer == 0 ? WSB(WS_HBB) : nullptr, layer == 0 ? WSF(ssp) : nullptr, WSF(ssf), WSB(WS_T + T_PP)}; pg8::gemm_phase(lds, g, S, E, wv);
#endif
        }
        if constexpr (layer == 0) xcd_barrier(xb);
    }
}

__global__ void __launch_bounds__(NT, 2) fwd_megakernel(Params P_raw) {
    const KArgs P;
    extern __shared__ __attribute__((aligned(16))) unsigned char lds_raw[];
    LAS unsigned char* lds = (LAS unsigned char*)lds_raw;
    cg::grid_group grid = cg::this_grid();
    const int G = gridDim.x, c = blockIdx.x, wv = __builtin_amdgcn_readfirstlane(threadIdx.x >> 6);
    pg8::StaticOrder S;
    { unsigned* bw = (unsigned*)(P.ws() + WS_BAR); if (c == 0) { for (int i = threadIdx.x; i < XCD_BAR_WORDS; i += NT) bw[i] = 0u; if (threadIdx.x < 128) ((unsigned*)(P.ws() + WS_QCTR))[threadIdx.x] = 0u; }
      if (threadIdx.x < 4) ((LAS unsigned*)(lds + 131072))[threadIdx.x] = 0u; }
    __syncthreads();
    grid.sync();
    XcdBarrier xb = xcd_barrier_post((unsigned*)(P.ws() + WS_BAR), (volatile LAS unsigned*)(lds + 131072)); xb.wv = wv;

    prep_layer(lds, P, 0, G, c, wv);
    prep_x(P, G, c, wv);
    xcd_barrier(xb);
    { pg8::Gemm g{WSB(WS_HBA), WSB(WS_W + W_A), DM, DM, DM, 0}; S.init(MTOK, 4096, G, c, wv);
      pg8::EpiQK E{WSB(WS_T + T_QK), WSF(WS_SS), P.in(I_GQ), P.in(I_GK), (LAS float*)(lds + 131072 + 1024)}; pg8::gemm_phase(lds, g, S, E, wv); }
    { pg8::Gemm g{WSB(WS_W + W_B), WSB(WS_HBA), DM, DM, DM, 0}; S.init(DM, MTOK, G, c, wv);
      pg8::EpiBf16<0, 2> E{WSB(WS_T + T_VT), MTOK, WSF(WS_SS), 0, 0}; pg8::gemm_phase(lds, g, S, E, wv); }
    xcd_barrier(xb);
    attn_phase(lds, P, G, c, wv);
    xcd_barrier(xb);
    layer_tail<0>(lds, P, xb, G, c, wv);
    layer_tail<1>(lds, P, xb, G, c, wv);
}

extern "C" void kernel_launch(void* const* d_in, const int* in_sizes, int n_in, void* d_out, int out_size, void* d_ws, size_t ws_size, hipStream_t stream) {
    static int grid_blocks = 0;
    if (!grid_blocks) {
        if (n_in != 27 || ws_size < WS_END) { fprintf(stderr, "kernel_launch: unexpected n_in %d or ws_size %zu (< %zu)\n", n_in, ws_size, (size_t)WS_END); grid_blocks = -1; return; }
        int dev = 0, cus = 0, per_cu = 0;
        hipGetDevice(&dev);
        hipDeviceGetAttribute(&cus, hipDeviceAttributeMultiprocessorCount, dev);
        if (hipFuncSetAttribute((const void*)fwd_megakernel, hipFuncAttributeMaxDynamicSharedMemorySize, LDS_BYTES) != hipSuccess) { fprintf(stderr, "kernel_launch: hipFuncSetAttribute failed\n"); grid_blocks = -1; return; }
        hipOccupancyMaxActiveBlocksPerMultiprocessor(&per_cu, fwd_megakernel, NT, LDS_BYTES);
        if (per_cu < 1) { fprintf(stderr, "kernel_launch: occupancy query returned %d\n", per_cu); per_cu = 1; }
        grid_blocks = cus * 1;
    }
    if (grid_blocks < 0) return;
    Params p{};
    for (int i = 0; i < 27; ++i) p.in[i] = (const float*)d_in[i];
    p.out = (float*)d_out; p.ws = (unsigned char*)d_ws;
    void* args[] = {&p};
    hipError_t e = hipLaunchCooperativeKernel((const void*)fwd_megakernel, dim3(grid_blocks), dim3(NT), args, LDS_BYTES, stream);
    if (e != hipSuccess) fprintf(stderr, "cooperative launch failed: %s (grid %d)\n", hipGetErrorString(e), grid_blocks);
}
```

```cpp
#include <hip/hip_runtime.h>
#include <hip/hip_cooperative_groups.h>
#include <cstdio>
namespace cg = cooperative_groups;

#define LAS __attribute__((address_space(3)))
typedef unsigned short bf16_t;
typedef short bf16x8 __attribute__((ext_vector_type(8)));
typedef float f32x4 __attribute__((ext_vector_type(4)));
typedef float f32x2 __attribute__((ext_vector_type(2)));
typedef float f32x16 __attribute__((ext_vector_type(16)));
typedef unsigned u32x4 __attribute__((ext_vector_type(4)));
typedef unsigned u32x2 __attribute__((ext_vector_type(2)));
typedef __bf16 bf2_t __attribute__((ext_vector_type(2)));

constexpr int MTOK = 16384, DM = 2048, SEQ = 4096, DFF = 8192, DPLE = 256;
constexpr float EPS = 1e-6f;
constexpr float LOG2E = 1.4426950408889634f;
#ifndef RESID_BF16
#define RESID_BF16 1
#endif
constexpr int NT = 512;
constexpr int LDS_BYTES = 131072 + 1024 + 8192;

constexpr size_t MiB = 1024 * 1024;
constexpr size_t WS_SS = 0;
constexpr size_t WS_SP = 512 * 1024;
constexpr size_t WS_BAR = 768 * 1024;
constexpr size_t WS_QCTR = WS_BAR + 16 * 1024;
constexpr size_t WS_PB = 1 * MiB;
constexpr size_t WS_W = 9 * MiB;
constexpr size_t WS_HBA = 115 * MiB;
constexpr size_t WS_HBB = 179 * MiB;
constexpr size_t WS_T = 243 * MiB;
constexpr size_t WS_END = 563 * MiB;
constexpr size_t W_A = 0;
constexpr size_t W_B = 16 * MiB;
constexpr size_t W_O = 24 * MiB;
constexpr size_t W_UP = 32 * MiB;
constexpr size_t W_DN = 64 * MiB;
constexpr size_t W_PG = 96 * MiB;
constexpr size_t W_PP = 104 * MiB;
constexpr size_t T_QK = 0;
constexpr size_t T_VT = 128 * MiB;
constexpr size_t T_O = 192 * MiB;
constexpr size_t T_U = 0;
constexpr size_t T_PP = 256 * MiB;
constexpr size_t T_Y = 0;
constexpr size_t T_XR = 64 * MiB;
constexpr size_t T_A = 128 * MiB;
constexpr size_t T_BQ = 256 * MiB;
constexpr size_t T_PS = 192 * MiB;

__device__ __forceinline__ unsigned pk_bf16(float lo, float hi) {
    f32x2 v = {lo, hi};
    bf2_t r = __builtin_convertvector(v, bf2_t);
    return __builtin_bit_cast(unsigned, r);
}
__device__ __forceinline__ int opaque_tid(int wv) { int l; asm volatile("v_mbcnt_lo_u32_b32 %0, -1, 0\n\tv_mbcnt_hi_u32_b32 %0, -1, %0" : "=v"(l)); return wv * 64 + l; }
__device__ __forceinline__ float bf_lo(unsigned w) { return __uint_as_float(w << 16); }
__device__ __forceinline__ float bf_hi(unsigned w) { return __uint_as_float(w & 0xffff0000u); }
__device__ __forceinline__ float fast_sigmoid(float x) { return __builtin_amdgcn_rcpf(1.0f + __builtin_amdgcn_exp2f(-x * LOG2E)); }
__device__ __forceinline__ float ss_fix(float raw) { return (float)__float_as_uint(raw) * (1.0f / 256.0f); }
__device__ __forceinline__ unsigned ss_enc(float sq) { return (unsigned)(sq * 256.0f + 0.5f); }
__device__ __forceinline__ float row_rs(const float* ss, int row) { return __builtin_amdgcn_rsqf(ss_fix(ss[row]) * (1.0f / DM) + EPS); }

namespace pg8 {
constexpr int BM = 256, BK = 64, HALF = 128, HTB = HALF * BK * 2, STAGE_BYTES = 8 * HTB, NXCD = 8, WGM = 8;
__device__ __forceinline__ int lds_byte(int r, int c) { const int st = (r >> 4) * 2 + (c >> 5), rr = r & 15, cc = c & 31, ob = rr * 64 + cc * 2; return st * 1024 + (ob ^ (((ob >> 9) & 1) << 5)); }
__device__ __forceinline__ void stage_rc(int b, int& R, int& C) { const int st = b / 1024, sb = b % 1024, swz = sb ^ (((sb >> 9) & 1) << 5); R = (st >> 1) * 16 + swz / 64; C = (st & 1) * 32 + (swz % 64) / 2; }
__device__ __forceinline__ int perm32(int rho) { const int n = rho >> 4, i = rho & 15; return 8 * (i >> 2) + 4 * n + (i & 3); }

struct Unit { int pm, pn; };
struct Gemm { const bf16_t* A; const bf16_t* Bt; int lda, ldb, K, adiag; };

struct StaticOrder {
    int nM, nN, nwg, G, c, wgm;
    __device__ void init(int M, int N, int G_, int c_, int) { nM = M / BM; nN = N / BM; nwg = nM * nN; G = G_; c = c_; wgm = (nN == 8) ? 4 : WGM; }
    __device__ bool next(int i, Unit& u) const {
        const long L = (long)i * G + c; if (L >= nwg) return false;
        int wgid = (int)L; { const int q = nwg / NXCD, r = nwg % NXCD, xcd = wgid % NXCD, off = wgid / NXCD; wgid = (xcd < r ? xcd * (q + 1) : r * (q + 1) + (xcd - r) * q) + off; }
        const int nig = wgm * nN, gid = wgid / nig, fm = gid * wgm, gsz = (nM - fm) < wgm ? (nM - fm) : wgm;
        u.pm = fm + ((wgid % nig) % gsz); u.pn = (wgid % nig) / gsz; return true;
    }
};

template <class Epi>
__device__ __forceinline__ void gemm_phase(LAS unsigned char* lds, const Gemm g, const StaticOrder& S, const Epi& E, int wv) {
    const int tid = opaque_tid(wv), wid = __builtin_amdgcn_readfirstlane(tid >> 6), lane = tid & 63, wr = wid >> 2, wc = wid & 3, fr = lane & 15, fq = lane >> 4;
    const int K = g.K, nt = K / BK;
    unsigned voffA[2], voffB[2];
#pragma unroll
    for (int i = 0; i < 2; ++i) { int R, C; stage_rc(tid * 16 + i * 8192, R, C); const int Rb = Epi::PERM ? ((R & ~31) + perm32(R & 31)) : R;
        voffA[i] = (unsigned)(R * g.lda + C) * 2u; voffB[i] = (unsigned)(Rb * g.ldb + C) * 2u; }
    const bool krev = (g.adiag & 2) != 0;
    const ptrdiff_t kstep = krev ? -(ptrdiff_t)(BK * 2) : (ptrdiff_t)(BK * 2);
    const size_t kbeg = krev ? (size_t)(nt - 1) * (BK * 2) : 0;
    const size_t hstepA = (size_t)HALF * g.lda * 2, hstepB = (size_t)HALF * g.ldb * 2;
    const size_t tstepA = 2 * hstepA, tstepB = 2 * hstepB;
    const unsigned ldsw = (unsigned)wid * 1024u;
    const int aoff = lds_byte(wr * 64 + fr, fq * 8), boff = lds_byte(wc * 32 + fr, fq * 8);
#define PG8_SA(b, h) (((b) * 2 + (h)) * HTB)
#define PG8_SB(b, h) ((4 + (b) * 2 + (h)) * HTB)
#define PG8_STAGE(bufoff, gbase, voff) do { _Pragma("unroll") for (int _i = 0; _i < 2; ++_i) \
        __builtin_amdgcn_global_load_lds((const unsigned*)((const char*)(gbase) + (voff)[_i]), (LAS unsigned*)(lds + (bufoff) + ldsw + _i * 8192), 16, 0, 0); } while (0)
#define PG8_LDA(dst, b, h) do { _Pragma("unroll") for (int m = 0; m < 4; ++m) _Pragma("unroll") for (int k = 0; k < 2; ++k) dst[m][k] = *(const LAS bf16x8*)(lds + PG8_SA(b, h) + aoff + m * 2048 + k * 1024); } while (0)
#define PG8_LDB(dst, b, h) do { _Pragma("unroll") for (int n = 0; n < 2; ++n) _Pragma("unroll") for (int k = 0; k < 2; ++k) dst[n][k] = *(const LAS bf16x8*)(lds + PG8_SB(b, h) + boff + n * 2048 + k * 1024); } while (0)
#define PG8_MMA(ai, bj, At, Bt) do { __builtin_amdgcn_s_setprio(1); _Pragma("unroll") for (int m = 0; m < 4; ++m) _Pragma("unroll") for (int n = 0; n < 2; ++n) _Pragma("unroll") for (int k = 0; k < 2; ++k) \
        acc[ai][bj][m][n] = __builtin_amdgcn_mfma_f32_16x16x32_bf16(Bt[n][k], At[m][k], acc[ai][bj][m][n], 0, 0, 0); __builtin_amdgcn_s_setprio(0); } while (0)
#define PG8_WAIT_V(n) asm volatile("s_waitcnt vmcnt(" #n ")" ::: "memory")
#define PG8_WAIT_L(n) asm volatile("s_waitcnt lgkmcnt(" #n ")" ::: "memory")
#define PG8_BAR __builtin_amdgcn_s_barrier()
#define PG8_SCHED __builtin_amdgcn_sched_barrier(0)
    Unit cur, nxt; int ui = 0;
    if (!S.next(0, cur)) return;
    f32x4 acc[2][2][4][2];
#pragma unroll
    for (int a = 0; a < 2; ++a)
#pragma unroll
        for (int b = 0; b < 2; ++b)
#pragma unroll
            for (int m = 0; m < 4; ++m)
#pragma unroll
                for (int n = 0; n < 2; ++n) acc[a][b][m][n] = (f32x4){0.f, 0.f, 0.f, 0.f};
    bf16x8 At[4][2], B0[2][2], B1[2][2];
    const char* cA = (const char*)g.A + (size_t)cur.pm * tstepA + ((g.adiag & 1) ? (size_t)(cur.pn >> 1) * K * 2 : 0) + kbeg;
    const char* cB = (const char*)g.Bt + (size_t)cur.pn * tstepB + kbeg;
    PG8_STAGE(PG8_SB(0, 0), cB, voffB); PG8_STAGE(PG8_SA(0, 0), cA, voffA); PG8_STAGE(PG8_SB(0, 1), cB + hstepB, voffB); PG8_STAGE(PG8_SA(0, 1), cA + hstepA, voffA);
    if (wr == 1) PG8_BAR;
    PG8_WAIT_V(4); PG8_BAR;
    PG8_STAGE(PG8_SB(1, 0), cB + kstep, voffB); PG8_STAGE(PG8_SA(1, 0), cA + kstep, voffA); PG8_STAGE(PG8_SB(1, 1), cB + hstepB + kstep, voffB);
    PG8_WAIT_V(6); PG8_BAR;
    for (;;) {
        const bool has_next = S.next(ui + 1, nxt);
        const char* nA = has_next ? (const char*)g.A + (size_t)nxt.pm * tstepA + ((g.adiag & 1) ? (size_t)(nxt.pn >> 1) * K * 2 : 0) + kbeg : cA;
        const char* nB = has_next ? (const char*)g.Bt + (size_t)nxt.pn * tstepB + kbeg : cB;
        for (int t = 0; t < nt; t += 2) {
            const bool last = (t == nt - 2);
            const char* a1 = cA + (ptrdiff_t)(t + 1) * kstep;
            const char* a2 = last ? nA : cA + (ptrdiff_t)(t + 2) * kstep; const char* b2 = last ? nB : cB + (ptrdiff_t)(t + 2) * kstep;
            const char* a3 = a2 + kstep; const char* b3 = b2 + kstep;
            PG8_LDB(B0, 0, 0); PG8_SCHED; PG8_LDA(At, 0, 0); PG8_STAGE(PG8_SA(1, 1), a1 + hstepA, voffA);
            PG8_WAIT_L(8); PG8_BAR; PG8_WAIT_L(0); PG8_MMA(0, 0, At, B0); PG8_BAR; PG8_SCHED;
            PG8_LDB(B1, 0, 1); PG8_STAGE(PG8_SB(0, 0), b2, voffB);
            PG8_BAR; PG8_WAIT_L(0); PG8_MMA(0, 1, At, B1); PG8_BAR;
            PG8_LDA(At, 0, 1); PG8_STAGE(PG8_SA(0, 0), a2, voffA);
            PG8_BAR; PG8_WAIT_L(0); PG8_MMA(1, 0, At, B0); PG8_BAR; PG8_SCHED;
            PG8_STAGE(PG8_SB(0, 1), b2 + hstepB, voffB);
            PG8_WAIT_V(6); PG8_BAR; PG8_MMA(1, 1, At, B1); PG8_BAR;
            PG8_LDB(B0, 1, 0); PG8_SCHED; PG8_LDA(At, 1, 0); PG8_STAGE(PG8_SA(0, 1), a2 + hstepA, voffA);
            PG8_WAIT_L(8); PG8_BAR; PG8_WAIT_L(0); PG8_MMA(0, 0, At, B0); PG8_BAR; PG8_SCHED;
            PG8_LDB(B1, 1, 1); PG8_STAGE(PG8_SB(1, 0), b3, voffB);
            PG8_BAR; PG8_WAIT_L(0); PG8_MMA(0, 1, At, B1); PG8_BAR;
            PG8_LDA(At, 1, 1); PG8_STAGE(PG8_SA(1, 0), a3, voffA);
            PG8_BAR; PG8_WAIT_L(0); PG8_MMA(1, 0, At, B0); PG8_BAR; PG8_SCHED;
            PG8_STAGE(PG8_SB(1, 1), b3 + hstepB, voffB);
            PG8_WAIT_V(6); PG8_BAR; PG8_MMA(1, 1, At, B1); PG8_BAR;
        }
        E(acc, cur, wr, wc, fr, fq);
        if (!has_next) break;
#pragma unroll
        for (int a = 0; a < 2; ++a)
#pragma unroll
            for (int b = 0; b < 2; ++b)
#pragma unroll
                for (int m = 0; m < 4; ++m)
#pragma unroll
                    for (int n = 0; n < 2; ++n) acc[a][b][m][n] = (f32x4){0.f, 0.f, 0.f, 0.f};
        cur = nxt; cA = nA; cB = nB; ++ui;
    }
    PG8_WAIT_V(0);
    if (wr == 0) PG8_BAR;
    PG8_BAR;
#undef PG8_SA
#undef PG8_SB
#undef PG8_STAGE
#undef PG8_LDA
#undef PG8_LDB
#undef PG8_MMA
#undef PG8_WAIT_V
#undef PG8_WAIT_L
#undef PG8_BAR
#undef PG8_SCHED
}

template <int ACT, int SM> struct EpiBf16 {
    static constexpr bool PERM = true;
    bf16_t* O; int ldc; const float* ss; int split_cols; size_t split_stride;
    __device__ __forceinline__ void operator()(const f32x4 (&acc)[2][2][4][2], const Unit& u, int wr, int wc, int fr, int fq) const {
        const int row0 = u.pm * BM + wr * 64 + fr; int colt = u.pn * BM; bf16_t* base = O; int tsel = 0;
        if (split_cols) { tsel = colt / split_cols; base += (size_t)tsel * split_stride; colt -= tsel * split_cols; }
        const int col0 = colt + wc * 32 + 8 * fq;
        f32x4 cs[2][2];
        if (SM == 2) {
#pragma unroll
            for (int bj = 0; bj < 2; ++bj)
#pragma unroll
                for (int n = 0; n < 2; ++n) { const f32x4 s = *(const f32x4*)(ss + u.pn * BM + wc * 32 + 8 * fq + bj * HALF + 4 * n);
#pragma unroll
                    for (int j = 0; j < 4; ++j) cs[bj][n][j] = __builtin_amdgcn_rsqf(ss_fix(s[j]) * (1.0f / DM) + EPS); }
        }
        float rsv[8];
#pragma unroll
        for (int it = 0; it < 8; ++it) rsv[it] = (SM == 1) ? ss[row0 + (it >> 2) * HALF + (it & 3) * 16] : 1.0f;
#pragma unroll
        for (int ai = 0; ai < 2; ++ai)
#pragma unroll
            for (int m = 0; m < 4; ++m) { const int row = row0 + ai * HALF + m * 16; float rs = 1.0f; if (SM == 1) rs = __builtin_amdgcn_rsqf(ss_fix(rsv[ai * 4 + m]) * (1.0f / DM) + EPS);
                bf16_t* rowp = base + (size_t)row * ldc + col0;
#pragma unroll
                for (int bj = 0; bj < 2; ++bj) { f32x4 v0 = acc[ai][bj][m][0], v1 = acc[ai][bj][m][1];
                    if (SM == 1) { v0 *= rs; v1 *= rs; }
                    if (SM == 2) { v0 *= cs[bj][0]; v1 *= cs[bj][1]; }
                    if (ACT == 1) {
#pragma unroll
                        for (int j = 0; j < 4; ++j) { const float a = fmaxf(v0[j], 0.f), b = fmaxf(v1[j], 0.f); v0[j] = a * a; v1[j] = b * b; } }
                    if (ACT == 2) { if (tsel == 0) {
#pragma unroll
                        for (int j = 0; j < 4; ++j) { const float a = v0[j], b = v1[j];
                            v0[j] = a * fast_sigmoid(1.5957691216057308f * (a + 0.044715f * a * a * a)); v1[j] = b * fast_sigmoid(1.5957691216057308f * (b + 0.044715f * b * b * b)); } } }
                    u32x4 w; w.x = pk_bf16(v0[0], v0[1]); w.y = pk_bf16(v0[2], v0[3]); w.z = pk_bf16(v1[0], v1[1]); w.w = pk_bf16(v1[2], v1[3]);
                    *(u32x4*)(rowp + bj * HALF) = w; } }
    }
};
struct EpiQK {
    static constexpr bool PERM = true;
    bf16_t* O; const float* ss; const float* gq; const float* gk; LAS float* P;
    __device__ __forceinline__ void operator()(const f32x4 (&acc)[2][2][4][2], const Unit& u, int wr, int wc, int fr, int fq) const {
        const int row0 = u.pm * BM + wr * 64 + fr, col0 = u.pn * BM + wc * 32 + 8 * fq;
        const bool isq = u.pn < 8;
        const float* gp = (isq ? gq : gk) + wc * 32 + 8 * fq;
        const float qs = isq ? 0.08838834764831845f * LOG2E : 1.0f;
        const f32x4 g0 = *(const f32x4*)gp * qs, g1 = *(const f32x4*)(gp + 4) * qs;
        float rsv[8];
#pragma unroll
        for (int it = 0; it < 8; ++it) rsv[it] = __builtin_amdgcn_rsqf(ss_fix(ss[row0 + (it >> 2) * HALF + (it & 3) * 16]) * (1.0f / DM) + EPS);
#pragma unroll
        for (int it = 0; it < 8; ++it) { const int ai = it >> 2, m = it & 3; const float rs = rsv[it];
#pragma unroll
            for (int bj = 0; bj < 2; ++bj) { const f32x4 v0 = acc[ai][bj][m][0] * rs, v1 = acc[ai][bj][m][1] * rs;
                float sq = (v0[0] * v0[0] + v0[1] * v0[1]) + (v0[2] * v0[2] + v0[3] * v0[3]) + (v1[0] * v1[0] + v1[1] * v1[1]) + (v1[2] * v1[2] + v1[3] * v1[3]);
                sq += __shfl_xor(sq, 16); sq += __shfl_xor(sq, 32);
                if (fq == 0) P[((ai * HALF + wr * 64 + m * 16 + fr) * 2 + bj) * 4 + wc] = sq; } }
        asm volatile("s_waitcnt lgkmcnt(0)" ::: "memory"); __builtin_amdgcn_s_barrier(); asm volatile("" ::: "memory");
#pragma unroll
        for (int it = 0; it < 8; ++it) { const int ai = it >> 2, m = it & 3; const float rs = rsv[it]; const int rl = ai * HALF + wr * 64 + m * 16 + fr;
            bf16_t* rowp = O + (size_t)(row0 + ai * HALF + m * 16) * 4096 + col0;
#pragma unroll
            for (int bj = 0; bj < 2; ++bj) { const f32x4 p4 = *(const LAS f32x4*)(P + (rl * 2 + bj) * 4);
                const float rn = __builtin_amdgcn_rsqf(((p4[0] + p4[1]) + (p4[2] + p4[3])) * (1.0f / 128.0f) + EPS) * rs;
                const f32x4 v0 = acc[ai][bj][m][0] * rn * g0, v1 = acc[ai][bj][m][1] * rn * g1;
                u32x4 w; w.x = pk_bf16(v0[0], v0[1]); w.y = pk_bf16(v0[2], v0[3]); w.z = pk_bf16(v1[0], v1[1]); w.w = pk_bf16(v1[2], v1[3]);
                *(u32x4*)(rowp + bj * HALF) = w; } }
    }
};
template <int MODE> struct EpiResid {
    static constexpr bool PERM = false;
    const float* hin; float* hout; bf16_t* hb; float* ss_out; const float* ss_in; const bf16_t* pp;
    __device__ __forceinline__ void operator()(const f32x4 (&acc)[2][2][4][2], const Unit& u, int wr, int wc, int fr, int fq) const {
        const int row0 = u.pm * BM + wr * 64 + fr, col0 = u.pn * BM + wc * 32 + 4 * fq;
        constexpr int RD = (MODE == 0) ? 3 : 2;
        f32x4 hbuf[RD][4]; u32x2 pbuf[RD][4]; float rsb[RD];
#define RES_LOAD(S, it) do { const size_t ro_ = (size_t)(row0 + ((it) >> 2) * HALF + ((it) & 3) * 16) * DM + col0; \
        _Pragma("unroll") for (int q_ = 0; q_ < 4; ++q_) { const size_t off_ = ro_ + (q_ >> 1) * HALF + (q_ & 1) * 16; hbuf[S][q_] = *(const f32x4*)(hin + off_); if (MODE == 1) pbuf[S][q_] = *(const u32x2*)(pp + off_); } \
        if (MODE == 1) rsb[S] = ss_in[row0 + ((it) >> 2) * HALF + ((it) & 3) * 16]; } while (0)
        RES_LOAD(0, 0); if (RD == 3) RES_LOAD(1 % RD, 1);
#pragma unroll
        for (int it = 0; it < 8; ++it) { const int ai = it >> 2, m = it & 3, sc = it % RD;
            if (it + RD - 1 < 8) RES_LOAD((it + RD - 1) % RD, it + RD - 1);
            asm volatile("" ::: "memory");
            const int row = row0 + ai * HALF + m * 16; const size_t ro = (size_t)row * DM + col0;
            float rs = 1.0f; if (MODE == 1) rs = __builtin_amdgcn_rsqf(ss_fix(rsb[sc]) * (1.0f / DM) + EPS);
            float sq = 0.f;
#pragma unroll
            for (int q = 0; q < 4; ++q) { const int bj = q >> 1, n = q & 1; const size_t off = ro + bj * HALF + n * 16;
                f32x4 v = acc[ai][bj][m][n];
                if (MODE == 1) { const u32x2 pw = pbuf[sc][q];
                    v[0] = fast_sigmoid(rs * v[0]) * bf_lo(pw.x); v[1] = fast_sigmoid(rs * v[1]) * bf_hi(pw.x); v[2] = fast_sigmoid(rs * v[2]) * bf_lo(pw.y); v[3] = fast_sigmoid(rs * v[3]) * bf_hi(pw.y); }
                const f32x4 o = hbuf[sc][q] + v;
                *(f32x4*)(hout + off) = o;
                if (hb) { u32x2 w; w.x = pk_bf16(o[0], o[1]); w.y = pk_bf16(o[2], o[3]); *(u32x2*)(hb + off) = w; }
                sq += (o[0] * o[0] + o[1] * o[1]) + (o[2] * o[2] + o[3] * o[3]); }
            if (ss_out) { sq += __shfl_xor(sq, 16); sq += __shfl_xor(sq, 32); if (fq == 0) atomicAdd((unsigned*)(ss_out + row), ss_enc(sq)); }
            asm volatile("" ::: "memory"); }
#undef RES_LOAD
    }
};
template <int MODE, int IN16, int OUT32> struct EpiResid16 {
    static constexpr bool PERM = true;
    const float* hin; const bf16_t* hin16; float* hout; bf16_t* hb; float* ss_out; const float* ss_in; const bf16_t* pp;
    __device__ __forceinline__ void operator()(const f32x4 (&acc)[2][2][4][2], const Unit& u, int wr, int wc, int fr, int fq) const {
        const int row0 = u.pm * BM + wr * 64 + fr, col0 = u.pn * BM + wc * 32 + 8 * fq;
        constexpr int RD = 3;
        f32x4 hbuf[RD][4]; u32x4 hraw[RD][2]; u32x4 pbuf[RD][2]; float rsb[RD];
#define RES_LOAD(S, it) do { const size_t ro_ = (size_t)(row0 + ((it) >> 2) * HALF + ((it) & 3) * 16) * DM + col0; \
        _Pragma("unroll") for (int b_ = 0; b_ < 2; ++b_) { const size_t off_ = ro_ + b_ * HALF; \
            if (IN16) hraw[S][b_] = *(const u32x4*)(hin16 + off_); else { hbuf[S][2 * b_] = *(const f32x4*)(hin + off_); hbuf[S][2 * b_ + 1] = *(const f32x4*)(hin + off_ + 4); } \
            if (MODE == 1) pbuf[S][b_] = *(const u32x4*)(pp + off_); } \
        if (MODE == 1) rsb[S] = ss_in[row0 + ((it) >> 2) * HALF + ((it) & 3) * 16]; } while (0)
        RES_LOAD(0, 0); RES_LOAD(1, 1);
#pragma unroll
        for (int it = 0; it < 8; ++it) { const int ai = it >> 2, m = it & 3, sc = it % RD;
            if (it + RD - 1 < 8) RES_LOAD((it + RD - 1) % RD, it + RD - 1);
            asm volatile("" ::: "memory");
            const int row = row0 + ai * HALF + m * 16; const size_t ro = (size_t)row * DM + col0;
            float rs = 1.0f; if (MODE == 1) rs = __builtin_amdgcn_rsqf(ss_fix(rsb[sc]) * (1.0f / DM) + EPS);
            float sq = 0.f;
#pragma unroll
            for (int bj = 0; bj < 2; ++bj) { const size_t off = ro + bj * HALF;
                f32x4 v0 = acc[ai][bj][m][0], v1 = acc[ai][bj][m][1];
                if (MODE == 1) { const u32x4 pw = pbuf[sc][bj];
                    v0[0] = fast_sigmoid(rs * v0[0]) * bf_lo(pw.x); v0[1] = fast_sigmoid(rs * v0[1]) * bf_hi(pw.x); v0[2] = fast_sigmoid(rs * v0[2]) * bf_lo(pw.y); v0[3] = fast_sigmoid(rs * v0[3]) * bf_hi(pw.y);
                    v1[0] = fast_sigmoid(rs * v1[0]) * bf_lo(pw.z); v1[1] = fast_sigmoid(rs * v1[1]) * bf_hi(pw.z); v1[2] = fast_sigmoid(rs * v1[2]) * bf_lo(pw.w); v1[3] = fast_sigmoid(rs * v1[3]) * bf_hi(pw.w); }
                f32x4 h0, h1;
                if (IN16) { const u32x4 hw = hraw[sc][bj]; h0 = (f32x4){bf_lo(hw.x), bf_hi(hw.x), bf_lo(hw.y), bf_hi(hw.y)}; h1 = (f32x4){bf_lo(hw.z), bf_hi(hw.z), bf_lo(hw.w), bf_hi(hw.w)}; }
                else { h0 = hbuf[sc][2 * bj]; h1 = hbuf[sc][2 * bj + 1]; }
                const f32x4 o0 = h0 + v0, o1 = h1 + v1;
                if (OUT32) { *(f32x4*)(hout + off) = o0; *(f32x4*)(hout + off + 4) = o1; }
                if (hb) { u32x4 w; w.x = pk_bf16(o0[0], o0[1]); w.y = pk_bf16(o0[2], o0[3]); w.z = pk_bf16(o1[0], o1[1]); w.w = pk_bf16(o1[2], o1[3]); *(u32x4*)(hb + off) = w; }
                sq += ((o0[0] * o0[0] + o0[1] * o0[1]) + (o0[2] * o0[2] + o0[3] * o0[3])) + ((o1[0] * o1[0] + o1[1] * o1[1]) + (o1[2] * o1[2] + o1[3] * o1[3])); }
            if (ss_out) { sq += __shfl_xor(sq, 16); sq += __shfl_xor(sq, 32); if (fq == 0) atomicAdd((unsigned*)(ss_out + row), ss_enc(sq)); }
            asm volatile("" ::: "memory"); }
#undef RES_LOAD
    }
};
struct EpiGates {
    static constexpr bool PERM = false;
    const bf16_t* xc; const float* b_ga; const float* b_gx; const float* lam; bf16_t* aout; bf16_t* bout;
    __device__ __forceinline__ void operator()(const f32x4 (&acc)[2][2][4][2], const Unit& u, int wr, int wc, int fr, int fq) const {
        const int row0 = u.pm * BM + wr * 64 + fr, ch0 = u.pn * HALF + wc * 32 + 4 * fq;
#pragma unroll
        for (int n = 0; n < 2; ++n) {
            const f32x4 ba = *(const f32x4*)(b_ga + ch0 + n * 16), bx = *(const f32x4*)(b_gx + ch0 + n * 16), sp = *(const f32x4*)(lam + ch0 + n * 16);
            u32x2 xall[8];
#pragma unroll
            for (int it = 0; it < 8; ++it) xall[it] = *(const u32x2*)(xc + (size_t)(row0 + (it >> 2) * HALF + (it & 3) * 16) * DM + ch0 + n * 16);
            asm volatile("" ::: "memory");
#pragma unroll
            for (int ai = 0; ai < 2; ++ai)
#pragma unroll
                for (int m = 0; m < 4; ++m) { const int row = row0 + ai * HALF + m * 16; const size_t off = (size_t)row * DM + ch0 + n * 16;
                    const u32x2 xw = xall[ai * 4 + m];
                    const float xv[4] = {bf_lo(xw.x), bf_hi(xw.x), bf_lo(xw.y), bf_hi(xw.y)};
                    f32x4 av; float bv[4];
#pragma unroll
                    for (int j = 0; j < 4; ++j) { const float r = fast_sigmoid(acc[ai][0][m][n][j] + ba[j]), ig = fast_sigmoid(acc[ai][1][m][n][j] + bx[j]);
                        const float la = sp[j] * r; const float la2 = __uint_as_float(pk_bf16(la * LOG2E, 0.f) << 16);
                        const float a = __builtin_amdgcn_exp2f(la2); const float x2 = 2.0f * la2 * 0.6931471805599453f; av[j] = la2;
                        const float om = (x2 > -0.03f) ? -(x2 * (1.0f + x2 * (0.5f + x2 * (1.0f / 6.0f + x2 * (1.0f / 24.0f))))) : (1.0f - a * a);
                        bv[j] = __builtin_amdgcn_sqrtf(om) * (ig * xv[j]); }
                    { u32x2 wa; wa.x = pk_bf16(av[0], av[1]); wa.y = pk_bf16(av[2], av[3]); *(u32x2*)(aout + off) = wa; }
                    u32x2 w; w.x = pk_bf16(bv[0], bv[1]); w.y = pk_bf16(bv[2], bv[3]); *(u32x2*)(bout + off) = w; }
        }
    }
};
}

__device__ __forceinline__ void conv_transpose(LAS unsigned char* lds, const float* src, int ld, int K, int N, bf16_t* dst, int ldd, const float* gain, int G, int c, int wv) {
    LAS bf16_t* tile = (LAS bf16_t*)lds;
    const int tid = opaque_tid(wv);
    const int nsub = (N & 255) ? 2 : 4, nw = 64 * nsub;
    const int ntk = K / 64, ntn = N / nw, ntl = ntk * ntn;
    f32x4 v[4][2], vn[4][2]; float g0 = 1.f, g1 = 1.f, gn0 = 1.f, gn1 = 1.f;
#define CT_LOAD(V, GA, GB, t_) do { const int tk_ = (t_) % ntk, tn_ = (t_) / ntk, k0_ = tk_ * 64, n0_ = tn_ * nw; \
        _Pragma("unroll") for (int s = 0; s < 4; ++s) if (s < nsub) { _Pragma("unroll") for (int i = 0; i < 2; ++i) { const int kk = (tid >> 4) + 32 * i; V[s][i] = __builtin_nontemporal_load((const f32x4*)(src + (size_t)(k0_ + kk) * ld + n0_ + s * 64 + (tid & 15) * 4)); } } \
        if (gain) { GA = gain[k0_ + (tid >> 4)]; GB = gain[k0_ + (tid >> 4) + 32]; } } while (0)
    if (c < ntl) CT_LOAD(v, g0, g1, c);
    for (int t = c; t < ntl; t += G) {
        const int tk = t % ntk, tn = t / ntk, k0 = tk * 64, n0 = tn * nw;
        if (t + G < ntl) CT_LOAD(vn, gn0, gn1, t + G);
#pragma unroll
        for (int s = 0; s < 4; ++s) if (s < nsub) {
#pragma unroll
            for (int i = 0; i < 2; ++i) { const int kk = (tid >> 4) + 32 * i; const f32x4 w = v[s][i] * (i ? g1 : g0);
#pragma unroll
                for (int j = 0; j < 4; ++j) tile[s * 4224 + ((tid & 15) * 4 + j) * 66 + kk] = (bf16_t)(pk_bf16(w[j], 0.f) & 0xffffu); } }
        __syncthreads();
#pragma unroll
        for (int s = 0; s < 4; ++s) if (s < nsub) {
            const int n = tid >> 3, k8 = (tid & 7) * 8; const LAS unsigned* tp = (const LAS unsigned*)(tile + s * 4224 + n * 66 + k8);
            u32x4 w; w.x = tp[0]; w.y = tp[1]; w.z = tp[2]; w.w = tp[3];
            *(u32x4*)(dst + (size_t)(n0 + s * 64 + n) * ldd + k0 + k8) = w; }
        __syncthreads();
#pragma unroll
        for (int s = 0; s < 4; ++s) { v[s][0] = vn[s][0]; v[s][1] = vn[s][1]; } g0 = gn0; g1 = gn1;
    }
#undef CT_LOAD
}

struct Params {
    const float* in[27];
    float* out;
    unsigned char* ws;
};
#define CAS __attribute__((address_space(4)))
struct KArgs {
    __device__ __forceinline__ const CAS char* base() const { const CAS char* ka = (const CAS char*)__builtin_amdgcn_kernarg_segment_ptr(); asm volatile("" : "+s"(ka)); return ka; }
    __device__ __forceinline__ const float* in(int i) const { return *(const float* const CAS*)(base() + 8 * i); }
    __device__ __forceinline__ float* out() const { return *(float* const CAS*)(base() + 8 * 27); }
    __device__ __forceinline__ unsigned char* ws() const { return *(unsigned char* const CAS*)(base() + 8 * 28); }
};
enum { I_X = 0, I_P, I_GMIX, I_GMLP, I_GPLE, I_WQKV, I_GQ, I_GK, I_LQ1, I_LK1, I_LQ2, I_LK2, I_GSUB, I_WOA, I_WIN, I_CONVW, I_CONVB, I_WGA, I_BGA, I_WGX, I_BGX, I_LAMR, I_WOR, I_WUP, I_WDN, I_WPP, I_WPG };

__device__ __forceinline__ void prep_layer(LAS unsigned char* lds, const KArgs& P, int layer, int G, int c, int wv) {
    unsigned char* W = P.ws() + WS_W;
    if (layer == 0) {
        conv_transpose(lds, P.in(I_WQKV), 6144, 2048, 4096, (bf16_t*)(W + W_A), 2048, P.in(I_GMIX), G, c, wv);
        conv_transpose(lds, P.in(I_WQKV) + 4096, 6144, 2048, 2048, (bf16_t*)(W + W_B), 2048, P.in(I_GMIX), G, c, wv);
        conv_transpose(lds, P.in(I_WOA), 2048, 2048, 2048, (bf16_t*)(W + W_O), 2048, nullptr, G, c, wv);
    } else {
        conv_transpose(lds, P.in(I_WIN), 4096, 2048, 4096, (bf16_t*)(W + W_A), 2048, P.in(I_GMIX) + DM, G, c, wv);
        for (int j = 0; j < 32; ++j) { const int nb = j >> 2, gate = (j >> 1) & 1, half = j & 1;
            const float* src = (gate ? P.in(I_WGX) : P.in(I_WGA)) + (size_t)nb * 65536 + half * 128;
            bf16_t* dst = (bf16_t*)(W + W_B) + (size_t)((2 * nb + half) * 256 + gate * 128) * 256;
            conv_transpose(lds, src, 256, 256, 128, dst, 256, nullptr, G, (c + j * 8) % G, wv); }
        conv_transpose(lds, P.in(I_WOR), 2048, 2048, 2048, (bf16_t*)(W + W_O), 2048, nullptr, G, c, wv);
        if (c == 0) { float* spt = (float*)(P.ws() + WS_SP); const float* lr = P.in(I_LAMR); for (int i = opaque_tid(wv); i < DM; i += NT) spt[i] = -8.0f * log1pf(__expf(-lr[i])); }
    }
    conv_transpose(lds, P.in(I_WUP) + (size_t)layer * DM * DFF, DFF, DM, DFF, (bf16_t*)(W + W_UP), DM, P.in(I_GMLP) + layer * DM, G, c, wv);
    conv_transpose(lds, P.in(I_WDN) + (size_t)layer * DM * DFF, DM, DFF, DM, (bf16_t*)(W + W_DN), DFF, nullptr, G, c, wv);
    conv_transpose(lds, P.in(I_WPG) + (size_t)layer * DM * DM, DM, DM, DM, (bf16_t*)(W + W_PG), DM, P.in(I_GPLE) + layer * DM, G, c, wv);
    conv_transpose(lds, P.in(I_WPP) + (size_t)layer * DPLE * DM, DM, DPLE, DM, (bf16_t*)(W + W_PP), DPLE, nullptr, G, c, wv);
    const float* p = P.in(I_P) + (size_t)layer * MTOK * DPLE; bf16_t* pb = (bf16_t*)(P.ws() + WS_PB);
    for (size_t i = ((size_t)c * NT + opaque_tid(wv)) * 4; i < (size_t)MTOK * DPLE; i += (size_t)G * NT * 4) { const f32x4 v = __builtin_nontemporal_load((const f32x4*)(p + i)); u32x2 w; w.x = pk_bf16(v[0], v[1]); w.y = pk_bf16(v[2], v[3]); *(u32x2*)(pb + i) = w; }
}

__device__ __forceinline__ void prep_x(const KArgs& P, int G, int c, int wv) {
    const float* x = P.in(I_X); bf16_t* hb = (bf16_t*)(P.ws() + WS_HBA); float* ss = (float*)(P.ws() + WS_SS);
    const int tid0 = opaque_tid(wv), wid = tid0 >> 6, lane = tid0 & 63;
    for (int row = c * 8 + wid; row < MTOK; row += G * 8) {
        float sq = 0.f;
#pragma unroll
        for (int i = 0; i < 8; ++i) { const size_t off = (size_t)row * DM + i * 256 + lane * 4; const f32x4 v = *(const f32x4*)(x + off);
            sq += (v[0] * v[0] + v[1] * v[1]) + (v[2] * v[2] + v[3] * v[3]); u32x2 w; w.x = pk_bf16(v[0], v[1]); w.y = pk_bf16(v[2], v[3]); *(u32x2*)(hb + off) = w; }
#pragma unroll
        for (int o = 32; o >= 1; o >>= 1) sq += __shfl_xor(sq, o);
        if (lane == 0) ss[row] = __uint_as_float(ss_enc(sq));
    }
    for (int i = c * NT + tid0; i < 5 * MTOK; i += G * NT) ss[MTOK + i] = 0.f;
}

__device__ __forceinline__ void qknorm_phase(const KArgs& P, int G, int c, int wv) {
    bf16_t* qk = (bf16_t*)(P.ws() + WS_T + T_QK);
    const int tid = opaque_tid(wv), chunk = tid >> 4, d8 = (tid & 15) * 8; const bool isq = chunk < 16;
    const float* gp = (isq ? P.in(I_GQ) : P.in(I_GK)) + d8; float g[8];
    const float qs = isq ? 0.08838834764831845f * LOG2E : 1.0f;
#pragma unroll
    for (int j = 0; j < 8; ++j) g[j] = gp[j] * qs;
    for (int row = c; row < MTOK; row += G) {
        u32x4* ptr = (u32x4*)(qk + (size_t)row * 4096 + chunk * 128 + d8); const u32x4 w = *ptr;
        float v[8] = {bf_lo(w.x), bf_hi(w.x), bf_lo(w.y), bf_hi(w.y), bf_lo(w.z), bf_hi(w.z), bf_lo(w.w), bf_hi(w.w)};
        float sq = 0.f;
#pragma unroll
        for (int j = 0; j < 8; ++j) sq += v[j] * v[j];
        sq += __shfl_xor(sq, 1); sq += __shfl_xor(sq, 2); sq += __shfl_xor(sq, 4); sq += __shfl_xor(sq, 8);
        const float rs = __builtin_amdgcn_rsqf(sq * (1.0f / 128.0f) + EPS);
        u32x4 o; o.x = pk_bf16(v[0] * rs * g[0], v[1] * rs * g[1]); o.y = pk_bf16(v[2] * rs * g[2], v[3] * rs * g[3]); o.z = pk_bf16(v[4] * rs * g[4], v[5] * rs * g[5]); o.w = pk_bf16(v[6] * rs * g[6], v[7] * rs * g[7]);
        *ptr = o;
    }
}

#define MFMA32(a, b, c) __builtin_amdgcn_mfma_f32_32x32x16_bf16((a), (b), (c), 0, 0, 0)
__device__ __forceinline__ float uniform_f(float v) { return __int_as_float(__builtin_amdgcn_readfirstlane(__float_as_int(v))); }
__device__ __forceinline__ void attn_stage(LAS unsigned char* lds, int buf, const bf16_t* kbase, const bf16_t* vbase, int k0, int wid, int lane) {
    if (wid < 4) {
        const int sub = wid >> 1;
#pragma unroll
        for (int j = 0; j < 8; ++j) {
            const int pi = wid * 8 + j, row = (pi & 15) * 4 + (lane >> 4), gch = (lane & 15) ^ (row & 15);
            const bf16_t* src = kbase + (size_t)(k0 + row) * 4096 + sub * 128 + gch * 8;
            __builtin_amdgcn_global_load_lds((const unsigned*)src, (LAS unsigned*)(lds + buf * 65536 + pi * 1024), 16, 0, 0);
        }
    } else {
#pragma unroll
        for (int j = 0; j < 8; ++j) {
            const int pi = wid * 8 + j, row = (pi - 32) * 8 + (lane >> 3), gch = (lane & 7) ^ ((row >> 1) & 7);
            const bf16_t* src = vbase + (size_t)row * MTOK + k0 + gch * 8;
            __builtin_amdgcn_global_load_lds((const unsigned*)src, (LAS unsigned*)(lds + buf * 65536 + pi * 1024), 16, 0, 0);
        }
    }
}

__device__ __forceinline__ void attn_phase(LAS unsigned char* lds, const KArgs& P, int G, int c, int wv) {
    const bf16_t* qk = (const bf16_t*)(P.ws() + WS_T + T_QK); const bf16_t* vT = (const bf16_t*)(P.ws() + WS_T + T_VT); bf16_t* og = (bf16_t*)(P.ws() + WS_T + T_O);
    const int tid = opaque_tid(wv), wid = __builtin_amdgcn_readfirstlane(tid >> 6), lane = tid & 63, r = lane & 31, hh = lane >> 5;
    const int sub = wid >> 2, wq = wid & 3;
    float lamv, Mb;
    { const float* gq = P.in(I_GQ); const float* gk = P.in(I_GK);
      float d1 = P.in(I_LQ1)[lane] * P.in(I_LK1)[lane] + P.in(I_LQ1)[lane + 64] * P.in(I_LK1)[lane + 64];
      float d2 = P.in(I_LQ2)[lane] * P.in(I_LK2)[lane] + P.in(I_LQ2)[lane + 64] * P.in(I_LK2)[lane + 64];
      float mq = fmaxf(fabsf(gq[lane]), fabsf(gq[lane + 64])), mk = fmaxf(fabsf(gk[lane]), fabsf(gk[lane + 64]));
#pragma unroll
      for (int o = 32; o >= 1; o >>= 1) { d1 += __shfl_xor(d1, o); d2 += __shfl_xor(d2, o); mq = fmaxf(mq, __shfl_xor(mq, o)); mk = fmaxf(mk, __shfl_xor(mk, o)); }
      lamv = uniform_f(__expf(d1) - __expf(d2) + 0.2f);
      Mb = uniform_f(11.313708498984761f * LOG2E * mq * mk * 1.01f + 0.5f); }
    const int pr = (r & 19) | ((r & 4) << 1) | ((r & 8) >> 1);
    if (sub == 0) __builtin_amdgcn_s_setprio(1); else __builtin_amdgcn_s_setprio(0);
    unsigned* qctr = (unsigned*)(P.ws() + WS_QCTR);
    volatile LAS unsigned* qslot = (volatile LAS unsigned*)(lds + 131072 + 16);
    if (tid == 0) { qslot[1] = (unsigned)__builtin_amdgcn_s_getreg((3 << 11) | 20) & 7u; qslot[2] = 0u; }
    for (;;) {
        if (tid == 0) { unsigned u; unsigned qcur = qslot[1], qhops = qslot[2];
            for (;;) { u = atomicAdd(qctr + qcur * 16, 1u); if (u < 128u || qhops == 7u) break; ++qhops; qcur = (qcur + 1u) & 7u; }
            qslot[1] = qcur; qslot[2] = qhops;
            *qslot = (u < 128u) ? qcur * 128u + u : 0xffffffffu; }
        __syncthreads();
        const unsigned code = *qslot;
        if (code == 0xffffffffu) break;
        const int qx = (int)(code >> 7), u = (int)(code & 127u), hsel = u >> 5, qb = 31 - (u & 31);
        const int hd = (qx & 1) ? (hsel == 0 ? 6 : hsel == 1 ? 5 : hsel == 2 ? 2 : 1) : (hsel == 0 ? 7 : hsel == 1 ? 4 : hsel == 2 ? 3 : 0);
        const int bh = (qx >> 1) * 8 + hd;
        const int b = bh >> 3, h = bh & 7;
        int lq = lane; asm volatile("" : "+v"(lq));
        const int q0 = qb * 128, qw = q0 + wq * 32, myq = qw + (lq & 31);
        const size_t tok0 = (size_t)b * SEQ;
        const bf16_t* kbase = qk + tok0 * 4096 + 2048 + h * 256;
        const bf16_t* vbase = vT + (size_t)(h * 256) * MTOK + tok0;
        bf16x8 qf[8];
        { const bf16_t* qp = qk + (tok0 + myq) * 4096 + h * 256 + sub * 128 + (lq >> 5) * 8;
#pragma unroll
          for (int ks = 0; ks < 8; ++ks) qf[ks] = *(const bf16x8*)(qp + ks * 16); }
        f32x16 O[8];
#pragma unroll
        for (int d = 0; d < 8; ++d)
#pragma unroll
            for (int i = 0; i < 16; ++i) O[d][i] = 0.f;
        float lsum = 0.f;
        const float sl2 = uniform_f(__builtin_amdgcn_exp2f(-(float)(h + 1)) * LOG2E);
        const int nkt = 2 * qb + 2;
        int kt0 = 0; { const float dmax = 160.0f / sl2; const int kmin = q0 - 63 - (int)dmax; if (kmin > 0) kt0 = (kmin + 63) >> 6; if (kt0 > nkt - 1) kt0 = nkt - 1; }
        { int lz0 = lane; asm volatile("" : "+v"(lz0)); attn_stage(lds, kt0 & 1, kbase, vbase, kt0 * 64, wid, lz0); }
        for (int kt = kt0; kt < nkt; ++kt) {
            asm volatile("s_waitcnt vmcnt(0)" ::: "memory");
            __syncthreads();
            int lz = lane; asm volatile("" : "+v"(lz));
            if (kt + 1 < nkt) attn_stage(lds, (kt + 1) & 1, kbase, vbase, (kt + 1) * 64, wid, lz);
            const int k0 = kt * 64;
            if (k0 <= qw + 31) {
                const int rz = lz & 31, hz = lz >> 5, prz = (rz & 19) | ((rz & 4) << 1) | ((rz & 8) >> 1);
                const LAS unsigned char* kb = lds + (kt & 1) * 65536 + sub * 16384 + prz * 256;
                const int kx = (hz ^ (prz & 15)) * 16;
                const LAS unsigned char* vb = lds + (kt & 1) * 65536 + 32768 + rz * 128;
                const int vx = (hz ^ ((rz >> 1) & 7)) * 16;
                const int rel0 = k0 + 8 * hz - (qw + rz);
                const float tb = sl2 * (float)rel0 - Mb;
                const bool diag = (k0 + 63 > qw);
#pragma unroll
                for (int half = 0; half < 2; ++half) {
#define KREAD(ks_) (*(const LAS bf16x8*)(kb + half * 8192 + ((32 * (ks_)) ^ kx)))
#define VREAD(i_) (*(const LAS bf16x8*)(vb + ((i_) >> 1) * 4096 + (((4 * half + 2 * ((i_) & 1)) * 16) ^ vx)))
                    f32x16 s;
#pragma unroll
                    for (int i = 0; i < 16; ++i) s[i] = 0.f;
                    bf16x8 fr4[2];
                    fr4[0] = KREAD(0);
                    __builtin_amdgcn_sched_barrier(0);
#pragma unroll
                    for (int ks = 0; ks < 8; ++ks) {
                        if (ks + 1 < 8) fr4[(ks + 1) & 1] = KREAD(ks + 1);
                        s = MFMA32(fr4[ks & 1], qf[ks], s);
                        __builtin_amdgcn_sched_barrier(0);
                    }
                    bf16x8 pf0, pf1;
                    { float pv[8];
#pragma unroll
                      for (int j = 0; j < 8; ++j) { const int cc = 32 * half + j;
                          float p = __builtin_amdgcn_exp2f(s[j] + (tb + sl2 * (float)cc));
                          if (diag && (rel0 + cc > 0)) p = 0.f;
                          pv[j] = p; lsum += p; }
                      u32x4 w; w.x = pk_bf16(pv[0], pv[1]); w.y = pk_bf16(pv[2], pv[3]); w.z = pk_bf16(pv[4], pv[5]); w.w = pk_bf16(pv[6], pv[7]);
                      pf0 = __builtin_bit_cast(bf16x8, w); }
                    __builtin_amdgcn_sched_barrier(0);
                    u32x4 w1; float pe = 0.f;
#pragma unroll
                    for (int d = 0; d < 8; ++d) {
                        O[d] = MFMA32(VREAD(2 * d), pf0, O[d]);
                        { const int cc = 32 * half + 16 + d;
                          float p = __builtin_amdgcn_exp2f(s[8 + d] + (tb + sl2 * (float)cc));
                          if (diag && (rel0 + cc > 0)) p = 0.f;
                          lsum += p;
                          if (d & 1) w1[d >> 1] = pk_bf16(pe, p); else pe = p; }
                        __builtin_amdgcn_sched_barrier(0);
                    }
                    pf1 = __builtin_bit_cast(bf16x8, w1);
#pragma unroll
                    for (int d = 0; d < 8; ++d) {
                        O[d] = MFMA32(VREAD(2 * d + 1), pf1, O[d]);
                        __builtin_amdgcn_sched_barrier(0);
                    }
#undef KREAD
#undef VREAD
                }
            }
        }
        __syncthreads();
        const float ltot = lsum + __shfl_xor(lsum, 32);
        const float inv = 1.0f / ltot;
        int le = lane; asm volatile("" : "+v"(le));
        LAS float* cb0 = (LAS float*)lds + wq * 64 + le; LAS float* cb1 = cb0 + 16384;
        asm volatile("" : "+v"(cb0), "+v"(cb1));
        if (sub == 1) {
#pragma unroll
            for (int d = 0; d < 8; ++d)
#pragma unroll
                for (int i = 0; i < 16; ++i) (d < 4 ? cb0 : cb1)[(((d & 3) * 16 + i) * 4) * 64] = O[d][i] * inv;
        }
        __syncthreads();
        if (sub == 0) {
            float sq = 0.f;
#pragma unroll
            for (int d = 0; d < 8; ++d)
#pragma unroll
                for (int i = 0; i < 16; ++i) { const float v = O[d][i] * inv - lamv * (d < 4 ? cb0 : cb1)[(((d & 3) * 16 + i) * 4) * 64]; O[d][i] = v; sq += v * v; }
            sq += __shfl_xor(sq, 32);
            const float rs = __builtin_amdgcn_rsqf(sq * (1.0f / 256.0f) + EPS) * 0.8f;
            bf16_t* orow = og + (tok0 + qw + (le & 31)) * DM + h * 256;
            const float* gs = P.in(I_GSUB); asm volatile("" : "+s"(gs));
#pragma unroll
            for (int d = 0; d < 8; ++d)
#pragma unroll
                for (int g4 = 0; g4 < 4; ++g4) { const int dv = 32 * d + 8 * g4 + 4 * (le >> 5); const f32x4 gv = *(const f32x4*)(gs + dv);
                    u32x2 w; w.x = pk_bf16(O[d][4 * g4] * rs * gv[0], O[d][4 * g4 + 1] * rs * gv[1]); w.y = pk_bf16(O[d][4 * g4 + 2] * rs * gv[2], O[d][4 * g4 + 3] * rs * gv[3]);
                    *(u32x2*)(orow + dv) = w; }
        }
        __syncthreads();
    }
    __builtin_amdgcn_s_setprio(0);
}

__device__ __forceinline__ void conv_phase(const KArgs& P, int G, int c, int wv) {
    const bf16_t* xr = (const bf16_t*)(P.ws() + WS_T + T_XR); bf16_t* xc = (bf16_t*)(P.ws() + WS_HBA);
    const float* cw = P.in(I_CONVW); const float* cbias = P.in(I_CONVB);
    const int tid = opaque_tid(wv), c8 = (tid & 255) * 8, rsel = tid >> 8;
    float w[4][8], bb[8];
#pragma unroll
    for (int j = 0; j < 8; ++j) { bb[j] = cbias[c8 + j];
#pragma unroll
        for (int k = 0; k < 4; ++k) w[k][j] = cw[k * DM + c8 + j]; }
    for (int run = c * 2 + rsel; run < MTOK / 32; run += G * 2) {
        const int row0 = run * 32; const bool head = (row0 & (SEQ - 1)) == 0;
        u32x4 seq[11];
#pragma unroll
        for (int k = 0; k < 3; ++k) seq[k] = head ? (u32x4){0u, 0u, 0u, 0u} : *(const u32x4*)(xr + (size_t)(row0 - 3 + k) * DM + c8);
#pragma unroll 1
        for (int sb = 0; sb < 4; ++sb) {
#pragma unroll
            for (int i = 0; i < 8; ++i) seq[3 + i] = *(const u32x4*)(xr + (size_t)(row0 + sb * 8 + i) * DM + c8);
#pragma unroll
            for (int i = 0; i < 8; ++i) {
                float acc[8];
#pragma unroll
                for (int j = 0; j < 8; ++j) acc[j] = bb[j];
#pragma unroll
                for (int k = 0; k < 4; ++k) { const u32x4 v = seq[i + k];
                    const float f[8] = {bf_lo(v.x), bf_hi(v.x), bf_lo(v.y), bf_hi(v.y), bf_lo(v.z), bf_hi(v.z), bf_lo(v.w), bf_hi(v.w)};
#pragma unroll
                    for (int j = 0; j < 8; ++j) acc[j] += w[k][j] * f[j]; }
                u32x4 o; o.x = pk_bf16(acc[0], acc[1]); o.y = pk_bf16(acc[2], acc[3]); o.z = pk_bf16(acc[4], acc[5]); o.w = pk_bf16(acc[6], acc[7]);
                *(u32x4*)(xc + (size_t)(row0 + sb * 8 + i) * DM + c8) = o;
            }
            seq[0] = seq[8]; seq[1] = seq[9]; seq[2] = seq[10];
        }
    }
}
constexpr int CHK = 64, NCHK = SEQ / CHK;
__device__ __forceinline__ void scan_a_phase(const KArgs& P, int G, int c, int wv) {
    const bf16_t* A = (const bf16_t*)(P.ws() + WS_T + T_A); const bf16_t* Bq = (const bf16_t*)(P.ws() + WS_T + T_BQ);
    float* PS = (float*)(P.ws() + WS_T + T_PS); float* HS = PS + 4 * NCHK * DM;
    for (int item = c * NT + opaque_tid(wv); item < 4 * NCHK * (DM / 4); item += G * NT) {
        const int c4 = item & (DM / 4 - 1), ck = (item >> 9) & (NCHK - 1), b = item >> 15;
        const size_t base = ((size_t)b * SEQ + ck * CHK) * DM + c4 * 4;
        f32x4 pa = {1.f, 1.f, 1.f, 1.f}, hv = {0.f, 0.f, 0.f, 0.f};
#pragma unroll 8
        for (int t = 0; t < CHK; ++t) { const u32x2 aw = *(const u32x2*)(A + base + (size_t)t * DM); const u32x2 bw = *(const u32x2*)(Bq + base + (size_t)t * DM);
            const f32x4 a = {__builtin_amdgcn_exp2f(bf_lo(aw.x)), __builtin_amdgcn_exp2f(bf_hi(aw.x)), __builtin_amdgcn_exp2f(bf_lo(aw.y)), __builtin_amdgcn_exp2f(bf_hi(aw.y))};
            const f32x4 bq = {bf_lo(bw.x), bf_hi(bw.x), bf_lo(bw.y), bf_hi(bw.y)}; pa *= a; hv = a * hv + bq; }
        const size_t si = (size_t)(b * NCHK + ck) * DM + c4 * 4;
        *(f32x4*)(PS + si) = pa; *(f32x4*)(HS + si) = hv;
    }
}
__device__ __forceinline__ void scan_b_phase(const KArgs& P, int G, int c, int wv) {
    const bf16_t* A = (const bf16_t*)(P.ws() + WS_T + T_A); const bf16_t* Bq = (const bf16_t*)(P.ws() + WS_T + T_BQ); bf16_t* Y = (bf16_t*)(P.ws() + WS_T + T_Y);
    const float* PS = (const float*)(P.ws() + WS_T + T_PS); const float* HS = PS + 4 * NCHK * DM;
    for (int item = c * NT + opaque_tid(wv); item < 4 * NCHK * (DM / 4); item += G * NT) {
        const int c4 = item & (DM / 4 - 1), ck = (item >> 9) & (NCHK - 1), b = item >> 15;
        f32x4 hv = {0.f, 0.f, 0.f, 0.f};
#pragma unroll 8
        for (int j = 0; j < ck; ++j) { const size_t si = (size_t)(b * NCHK + j) * DM + c4 * 4; hv = *(const f32x4*)(PS + si) * hv + *(const f32x4*)(HS + si); }
        const size_t base = ((size_t)b * SEQ + ck * CHK) * DM + c4 * 4;
#pragma unroll 8
        for (int t = 0; t < CHK; ++t) { const size_t o = base + (size_t)t * DM; const u32x2 aw = *(const u32x2*)(A + o); const f32x4 a = {__builtin_amdgcn_exp2f(bf_lo(aw.x)), __builtin_amdgcn_exp2f(bf_hi(aw.x)), __builtin_amdgcn_exp2f(bf_lo(aw.y)), __builtin_amdgcn_exp2f(bf_hi(aw.y))}; const u32x2 bw = *(const u32x2*)(Bq + o); const u32x2 yw = *(const u32x2*)(Y + o);
            const f32x4 bq = {bf_lo(bw.x), bf_hi(bw.x), bf_lo(bw.y), bf_hi(bw.y)}; hv = a * hv + bq;
            u32x2 ow; ow.x = pk_bf16(hv[0] * bf_lo(yw.x), hv[1] * bf_hi(yw.x)); ow.y = pk_bf16(hv[2] * bf_lo(yw.y), hv[3] * bf_hi(yw.y)); *(u32x2*)(Y + o) = ow; }
    }
}

#define XB_TMO      128
#define XB_XCNT(j)  (256  + 64 * (j))
#define XB_XSUB(j)  (1280 + 64 * (j))
#define XB_XGEN(j)  (2304 + 64 * (j))
#define XB_TOP      3328
#define XB_TOPGEN   3392
#define XCD_BAR_WORDS 3456
#define XB_SPIN_CAP (1u << 18)
__device__ __forceinline__ unsigned xb_ld(unsigned* p)              { return __hip_atomic_load(p, __ATOMIC_RELAXED, __HIP_MEMORY_SCOPE_AGENT); }
__device__ __forceinline__ unsigned xb_add(unsigned* p, unsigned v) { return __hip_atomic_fetch_add(p, v, __ATOMIC_RELAXED, __HIP_MEMORY_SCOPE_AGENT); }
__device__ __forceinline__ unsigned xb_xcc_id() { return (unsigned)__builtin_amdgcn_s_getreg((3 << 11) | 20) & 0xFu; }
#define XB_SPIN(cond, bar) do { unsigned _sp = 0; while (cond) { __builtin_amdgcn_s_sleep(1); \
    if ((++_sp & 255u) == 0u) { if (xb_ld(&(bar)[XB_TMO])) break; if (_sp > XB_SPIN_CAP) { atomicAdd(&(bar)[XB_TMO], 1u); break; } } } } while (0)
struct XcdBarrier { unsigned* bar; unsigned x; volatile LAS unsigned* st; int wv; };
__device__ __forceinline__ XcdBarrier xcd_barrier_post(unsigned* bar, volatile LAS unsigned* st) {
    XcdBarrier b; b.bar = bar; b.x = xb_xcc_id(); b.st = st; b.wv = 0;
    if (threadIdx.x == 0) (void)xb_add(&bar[XB_XCNT(b.x)], 1u);
    return b;
}
__device__ __forceinline__ void xcd_barrier_complete(unsigned* bar, unsigned x, unsigned& nloc, unsigned& nx) {
    const unsigned G = gridDim.x * gridDim.y * gridDim.z;
    unsigned sum, cnt, mine, sp = 0u;
    for (;;) {
        sum = 0u; cnt = 0u; mine = 0u;
#pragma unroll
        for (unsigned j = 0; j < 16; ++j) { const unsigned c = xb_ld(&bar[XB_XCNT(j)]); sum += c; cnt += (c > 0u) ? 1u : 0u; mine = (j == x) ? c : mine; }
        if (sum == G) break;
        __builtin_amdgcn_s_sleep(1);
        if ((++sp & 255u) == 0u) { if (xb_ld(&bar[XB_TMO])) break; if (sp > XB_SPIN_CAP) { atomicAdd(&bar[XB_TMO], 1u); break; } }
    }
    nloc = mine > 0u ? mine : 1u; nx = cnt > 0u ? cnt : 1u;
}
__device__ __forceinline__ void xcd_barrier(const XcdBarrier& b) {
    asm volatile("s_waitcnt vmcnt(0)" ::: "memory");
    __syncthreads();
    if (b.wv == 0 && __builtin_amdgcn_mbcnt_hi(~0u, __builtin_amdgcn_mbcnt_lo(~0u, 0u)) == 0u) {
        unsigned* bar = b.bar;
        __builtin_amdgcn_s_waitcnt(0);
        unsigned nloc = b.st[0], nx = b.st[1];
        if (nloc == 0u) { xcd_barrier_complete(bar, b.x, nloc, nx); b.st[0] = nloc; b.st[1] = nx; }
        const unsigned old = xb_add(&bar[XB_XSUB(b.x)], 1u);
        const unsigned gen = old / nloc;
        if (old + 1u == (gen + 1u) * nloc) {
            __builtin_amdgcn_fence(__ATOMIC_RELEASE, "agent");
            asm volatile("s_waitcnt vmcnt(0)" ::: "memory");
            const unsigned og = xb_add(&bar[XB_TOP], 1u);
            const unsigned tg = og / nx;
            if (og + 1u == (tg + 1u) * nx) xb_add(&bar[XB_TOPGEN], 1u);
            else XB_SPIN(xb_ld(&bar[XB_TOPGEN]) == tg, bar);
            __builtin_amdgcn_fence(__ATOMIC_ACQUIRE, "agent");
            xb_add(&bar[XB_XGEN(b.x)], 1u);
            asm volatile("s_waitcnt vmcnt(0)" ::: "memory");
        } else {
            XB_SPIN(xb_ld(&bar[XB_XGEN(b.x)]) == gen, bar);
            __builtin_amdgcn_fence(__ATOMIC_ACQUIRE, "agent");
            asm volatile("s_waitcnt vmcnt(0)" ::: "memory");
        }
    }
    __syncthreads();
}

#define WSB(off) ((bf16_t*)(P.ws() + (off)))
#define WSF(off) ((float*)(P.ws() + (off)))
template <int layer>
__device__ __forceinline__ void layer_tail(LAS unsigned char* lds, const KArgs& P, const XcdBarrier& xb, int G, int c, int wv) {
    pg8::StaticOrder S;
    {
        const size_t ssm = WS_SS + (size_t)(layer * 3 + 1) * MTOK * 4;
        const size_t ssf = ssm + MTOK * 4;
        const size_t ssp = ssf + MTOK * 4;
        if constexpr (layer == 1) {
            prep_layer(lds, P, 1, G, c, wv);
            xcd_barrier(xb);
            { pg8::Gemm g{WSB(WS_HBB), WSB(WS_W + W_A), DM, DM, DM, 0}; S.init(MTOK, 4096, G, c, wv);
              pg8::EpiBf16<2, 1> E{WSB(WS_T + T_Y), DM, WSF(WS_SS) + 3 * MTOK, 2048, (size_t)(T_XR - T_Y) / 2}; pg8::gemm_phase(lds, g, S, E, wv); }
            xcd_barrier(xb);
            conv_phase(P, G, c, wv);
            xcd_barrier(xb);
            { pg8::Gemm g{WSB(WS_HBA), WSB(WS_W + W_B), DM, 256, 256, 1}; S.init(MTOK, 4096, G, c, wv);
              pg8::EpiGates E{WSB(WS_HBA), P.in(I_BGA), P.in(I_BGX), WSF(WS_SP), WSB(WS_T + T_A), WSB(WS_T + T_BQ)}; pg8::gemm_phase(lds, g, S, E, wv); }
            xcd_barrier(xb);
            scan_a_phase(P, G, c, wv);
            xcd_barrier(xb);
            scan_b_phase(P, G, c, wv);
            xcd_barrier(xb);
        }
        { pg8::Gemm g{WSB(WS_T + (layer == 0 ? T_O : T_Y)), WSB(WS_W + W_O), DM, DM, DM, 0}; S.init(MTOK, DM, G, c, wv);
#if RESID_BF16
          if constexpr (layer == 0) { pg8::EpiResid16<0, 1, 0> E{nullptr, WSB(WS_HBA), nullptr, WSB(WS_HBB), WSF(ssm), nullptr, nullptr}; pg8::gemm_phase(lds, g, S, E, wv); }
          else { pg8::EpiResid16<0, 1, 0> E{nullptr, WSB(WS_HBB), nullptr, WSB(WS_HBB), WSF(ssm), nullptr, nullptr}; pg8::gemm_phase(lds, g, S, E, wv); }
#else
          pg8::EpiResid<0> E{layer == 0 ? P.in(I_X) : (const float*)P.out(), P.out(), WSB(WS_HBB), WSF(ssm), nullptr, nullptr}; pg8::gemm_phase(lds, g, S, E, wv);
#endif
        }
        xcd_barrier(xb);
        { pg8::Gemm g{WSB(WS_HBB), WSB(WS_W + W_UP), DM, DM, DM, 0}; S.init(MTOK, DFF, G, c, wv);
          pg8::EpiBf16<1, 1> E{WSB(WS_T + T_U), DFF, WSF(ssm), 0, 0}; pg8::gemm_phase(lds, g, S, E, wv);
        }
        xcd_barrier(xb);
        { pg8::Gemm g{WSB(WS_T + T_U), WSB(WS_W + W_DN), DFF, DFF, DFF, 2}; S.init(MTOK, DM, G, c, wv);
#if RESID_BF16
          pg8::EpiResid16<0, 1, 0> E{nullptr, WSB(WS_HBB), nullptr, WSB(WS_HBA), WSF(ssf), nullptr, nullptr}; pg8::gemm_phase(lds, g, S, E, wv);
#else
          pg8::EpiResid<0> E{P.out(), P.out(), WSB(WS_HBA), WSF(ssf), nullptr, nullptr}; pg8::gemm_phase(lds, g, S, E, wv);
#endif
        }
        { pg8::Gemm g{WSB(WS_PB), WSB(WS_W + W_PP), DPLE, DPLE, DPLE, 0}; S.init(MTOK, DM, G, c, wv);
          pg8::EpiBf16<0, 0> E{WSB(WS_T + T_PP), DM, nullptr, 0, 0}; pg8::gemm_phase(lds, g, S, E, wv); }
        xcd_barrier(xb);
        { pg8::Gemm g{WSB(WS_HBA), WSB(WS_W + W_PG), DM, DM, DM, 0}; S.init(MTOK, DM, G, c, wv);
#if RESID_BF16
          if constexpr (layer == 0) { pg8::EpiResid16<1, 1, 0> E{nullptr, WSB(WS_HBA), nullptr, WSB(WS_HBB), WSF(ssp), WSF(ssf), WSB(WS_T + T_PP)}; pg8::gemm_phase(lds, g, S, E, wv); }
          else { pg8::EpiResid16<1, 1, 1> E{nullptr, WSB(WS_HBA), P.out(), nullptr, nullptr, WSF(ssf), WSB(WS_T + T_PP)}; pg8::gemm_phase(lds, g, S, E, wv); }
#else
          pg8::EpiResid<1> E{P.out(), P.out(), layer == 0 ? WSB(WS_HBB) : nullptr, layer == 0 ? WSF(ssp) : nullptr, WSF(ssf), WSB(WS_T + T_PP)}; pg8::gemm_phase(lds, g, S, E, wv);
#endif
        }
        if constexpr (layer == 0) xcd_barrier(xb);
    }
}

__global__ void __launch_bounds__(NT, 2) fwd_megakernel(Params P_raw) {
    const KArgs P;
    extern __shared__ __attribute__((aligned(16))) unsigned char lds_raw[];
    LAS unsigned char* lds = (LAS unsigned char*)lds_raw;
    cg::grid_group grid = cg::this_grid();
    const int G = gridDim.x, c = blockIdx.x, wv = __builtin_amdgcn_readfirstlane(threadIdx.x >> 6);
    pg8::StaticOrder S;
    { unsigned* bw = (unsigned*)(P.ws() + WS_BAR); if (c == 0) { for (int i = threadIdx.x; i < XCD_BAR_WORDS; i += NT) bw[i] = 0u; if (threadIdx.x < 128) ((unsigned*)(P.ws() + WS_QCTR))[threadIdx.x] = 0u; }
      if (threadIdx.x < 4) ((LAS unsigned*)(lds + 131072))[threadIdx.x] = 0u; }
    __syncthreads();
    grid.sync();
    XcdBarrier xb = xcd_barrier_post((unsigned*)(P.ws() + WS_BAR), (volatile LAS unsigned*)(lds + 131072)); xb.wv = wv;

    prep_layer(lds, P, 0, G, c, wv);
    prep_x(P, G, c, wv);
    xcd_barrier(xb);
    { pg8::Gemm g{WSB(WS_HBA), WSB(WS_W + W_A), DM, DM, DM, 0}; S.init(MTOK, 4096, G, c, wv);
      pg8::EpiQK E{WSB(WS_T + T_QK), WSF(WS_SS), P.in(I_GQ), P.in(I_GK), (LAS float*)(lds + 131072 + 1024)}; pg8::gemm_phase(lds, g, S, E, wv); }
    { pg8::Gemm g{WSB(WS_W + W_B), WSB(WS_HBA), DM, DM, DM, 0}; S.init(DM, MTOK, G, c, wv);
      pg8::EpiBf16<0, 2> E{WSB(WS_T + T_VT), MTOK, WSF(WS_SS), 0, 0}; pg8::gemm_phase(lds, g, S, E, wv); }
    xcd_barrier(xb);
    attn_phase(lds, P, G, c, wv);
    xcd_barrier(xb);
    layer_tail<0>(lds, P, xb, G, c, wv);
    layer_tail<1>(lds, P, xb, G, c, wv);
}

extern "C" void kernel_launch(void* const* d_in, const int* in_sizes, int n_in, void* d_out, int out_size, void* d_ws, size_t ws_size, hipStream_t stream) {
    static int grid_blocks = 0;
    if (!grid_blocks) {
        if (n_in != 27 || ws_size < WS_END) { fprintf(stderr, "kernel_launch: unexpected n_in %d or ws_size %zu (< %zu)\n", n_in, ws_size, (size_t)WS_END); grid_blocks = -1; return; }
        int dev = 0, cus = 0, per_cu = 0;
        hipGetDevice(&dev);
        hipDeviceGetAttribute(&cus, hipDeviceAttributeMultiprocessorCount, dev);
        if (hipFuncSetAttribute((const void*)fwd_megakernel, hipFuncAttributeMaxDynamicSharedMemorySize, LDS_BYTES) != hipSuccess) { fprintf(stderr, "kernel_launch: hipFuncSetAttribute failed\n"); grid_blocks = -1; return; }
        hipOccupancyMaxActiveBlocksPerMultiprocessor(&per_cu, fwd_megakernel, NT, LDS_BYTES);
        if (per_cu < 1) { fprintf(stderr, "kernel_launch: occupancy query returned %d\n", per_cu); per_cu = 1; }
        grid_blocks = cus * 1;
    }
    if (grid_blocks < 0) return;
    Params p{};
    for (int i = 0; i < 27; ++i) p.in[i] = (const float*)d_in[i];
    p.out = (float*)d_out; p.ws = (unsigned char*)d_ws;
    void* args[] = {&p};
    hipError_t e = hipLaunchCooperativeKernel((const void*)fwd_megakernel, dim3(grid_blocks), dim3(NT), args, LDS_BYTES, stream);
    if (e != hipSuccess) fprintf(stderr, "cooperative launch failed: %s (grid %d)\n", hipGetErrorString(e), grid_blocks);
}
```
